# Optimizing an MI355X kernel written in HIP

```python
import jax, jax.numpy as jnp
from jax import lax
import numpy as np

D_MODEL = 1024
BATCH = 16
SEQ = 2048
DEPTH = 1

CHUNK = 64
PLE_DIM = 256
CONV_WIDTH = D_MODEL // 2
CONV_GROUPS = 8
CONV_K = 3
RWKV_WIDTH = D_MODEL - CONV_WIDTH
RWKV_HEAD = 64
RWKV_HEADS = RWKV_WIDTH // RWKV_HEAD
DECAY_LORA = 64
AICL_LORA = 64
GATE_LORA = 128
D_FF = 2816
FFN_CONV_K = 3
NORM_EPS = 1e-6
GN_EPS = 64e-5
RWKV_COLS = 3 * RWKV_WIDTH + DECAY_LORA + AICL_LORA + GATE_LORA
IN_COLS = 3 * CONV_WIDTH + RWKV_COLS

kernel_name = "hymba_shortconv_rwkv7_convffn_ple"


def rms_norm(x, g):
    xf = x.astype(jnp.float32)
    y = xf * lax.rsqrt(jnp.mean(xf * xf, axis=-1, keepdims=True) + NORM_EPS)
    return (y * g.astype(jnp.float32)).astype(x.dtype)


def causal_dwconv(x, w):
    k_width = w.shape[0]
    s = x.shape[1]
    xp = jnp.pad(x, ((0, 0), (k_width - 1, 0), (0, 0)))
    y = xp[:, k_width - 1:k_width - 1 + s] * w[k_width - 1]
    for j in range(k_width - 1):
        y = y + xp[:, j:j + s] * w[j]
    return y


def token_shift(z):
    return jnp.pad(z, ((0, 0), (1, 0), (0, 0)))[:, :-1]


def short_conv_mixer(z, conv_w):
    x_in, b_gate, c_gate = jnp.split(z, 3, axis=-1)
    return b_gate * causal_dwconv(c_gate * x_in, conv_w)


def wkv7_scan(r, w, k, v, kk, a):
    b, s, h, n = r.shape
    n_chunks = s // CHUNK

    def to_chunks(t):
        return t.reshape(b, n_chunks, CHUNK, h, n).transpose(1, 2, 0, 3, 4)

    xs = (to_chunks(r), to_chunks(w), to_chunks(k), to_chunks(v), to_chunks(kk), to_chunks(a))

    def step(state, inp):
        r_t, w_t, k_t, v_t, kk_t, a_t = inp
        sa = jnp.einsum('bhvk,bhk->bhv', state, -kk_t)
        state = (state * w_t[:, :, None, :]
                 + sa[..., None] * (kk_t * a_t)[:, :, None, :]
                 + v_t[..., None] * k_t[:, :, None, :])
        out = jnp.einsum('bhvk,bhk->bhv', state, r_t)
        return state, out

    def chunk_step(state, chunk_inp):
        return lax.scan(step, state, chunk_inp)

    state0 = jnp.zeros((b, h, n, n), jnp.float32)
    _, out = lax.scan(chunk_step, state0, xs)
    return out.transpose(2, 0, 1, 3, 4).reshape(b, s, h, n)


def rwkv7_mixer(z, mu, w0, w_up, a0, a_up, g_up, k_k, k_a, r_k, gn_w, gn_b):
    dtype = z.dtype
    bsz, s, _ = z.shape
    z = z.astype(jnp.float32)
    z = z + (token_shift(z) - z) * mu.astype(jnp.float32)
    c1 = RWKV_WIDTH
    r, k, v, wd, ad, gd = jnp.split(
        z, [c1, 2 * c1, 3 * c1, 3 * c1 + DECAY_LORA, 3 * c1 + DECAY_LORA + AICL_LORA], axis=-1)
    f32 = lambda t: t.astype(jnp.float32)
    w_log = -jax.nn.softplus(-(f32(w0) + jnp.tanh(wd) @ f32(w_up))) - 0.5
    decay = jnp.exp(-jnp.exp(w_log))
    a = jax.nn.sigmoid(f32(a0) + ad @ f32(a_up))
    g = jax.nn.sigmoid(gd) @ f32(g_up)
    heads = lambda t: t.reshape(bsz, s, RWKV_HEADS, RWKV_HEAD)
    kk = heads(k * f32(k_k))
    kk = kk * lax.rsqrt(jnp.maximum(jnp.sum(kk * kk, axis=-1, keepdims=True), 1e-24))
    k = k * (1.0 + (a - 1.0) * f32(k_a))
    rh, kh, vh, ah, wh = heads(r), heads(k), heads(v), heads(a), heads(decay)
    o = wkv7_scan(rh, wh, kh, vh, kk, ah)
    mean = jnp.mean(o, axis=-1, keepdims=True)
    var = jnp.mean(jnp.square(o - mean), axis=-1, keepdims=True)
    o = (o - mean) * lax.rsqrt(var + GN_EPS)
    o = o * heads(jnp.broadcast_to(f32(gn_w), (bsz, s, RWKV_WIDTH))) + heads(
        jnp.broadcast_to(f32(gn_b), (bsz, s, RWKV_WIDTH)))
    bonus = jnp.sum(rh * kh * f32(r_k), axis=-1, keepdims=True) * vh
    o = (o + bonus).reshape(bsz, s, RWKV_WIDTH) * g
    return o.astype(dtype)


def conv_glu_ffn(h, w_up, conv_w, conv_b, w_down):
    u = causal_dwconv(h @ w_up, conv_w) + conv_b
    gate, val = jnp.split(u, 2, axis=-1)
    return (jax.nn.silu(gate) * val) @ w_down


def setup_inputs(seed: int = 0) -> dict:
    key = jax.random.key(seed)
    ks = jax.random.split(key, 32)
    n = lambda k, shape, scale: jax.random.normal(k, shape, jnp.float32) * scale
    gain = lambda k, shape: 1.0 + 0.02 * jax.random.normal(k, shape, jnp.float32)
    L = DEPTH
    return {
        "x": n(ks[0], (BATCH, SEQ, D_MODEL), 1.0),
        "p": n(ks[1], (DEPTH, BATCH, SEQ, PLE_DIM), 1.0),
        "mix_norm_g": gain(ks[2], (L, D_MODEL)),
        "w_in": n(ks[3], (L, D_MODEL, IN_COLS), D_MODEL ** -0.5),
        "conv_mix_w": n(ks[4], (L, CONV_K, CONV_WIDTH), CONV_K ** -0.5),
        "rwkv_mu": jax.random.uniform(ks[5], (L, RWKV_COLS), jnp.float32),
        "rwkv_w0": jax.random.uniform(ks[6], (L, RWKV_WIDTH), jnp.float32, -4.0, 1.0),
        "rwkv_w_up": n(ks[7], (L, DECAY_LORA, RWKV_WIDTH), 0.1 * DECAY_LORA ** -0.5),
        "rwkv_a0": n(ks[8], (L, RWKV_WIDTH), 0.5),
        "rwkv_a_up": n(ks[9], (L, AICL_LORA, RWKV_WIDTH), 0.5 * AICL_LORA ** -0.5),
        "rwkv_g_up": n(ks[10], (L, GATE_LORA, RWKV_WIDTH), GATE_LORA ** -0.5),
        "rwkv_k_k": 0.85 + n(ks[11], (L, RWKV_WIDTH), 0.05),
        "rwkv_k_a": 1.0 + n(ks[12], (L, RWKV_WIDTH), 0.05),
        "rwkv_r_k": n(ks[13], (L, RWKV_HEADS, RWKV_HEAD), 0.1),
        "rwkv_gn_w": gain(ks[14], (L, RWKV_WIDTH)),
        "rwkv_gn_b": n(ks[15], (L, RWKV_WIDTH), 0.02),
        "w_out": n(ks[16], (L, D_MODEL, D_MODEL), D_MODEL ** -0.5),
        "ffn_norm_g": gain(ks[17], (L, D_MODEL)),
        "ffn_w_up": n(ks[18], (L, D_MODEL, 2 * D_FF), D_MODEL ** -0.5),
        "ffn_conv_w": n(ks[19], (L, FFN_CONV_K, 2 * D_FF), FFN_CONV_K ** -0.5),
        "ffn_conv_b": n(ks[20], (L, 2 * D_FF), 0.02),
        "ffn_w_down": n(ks[21], (L, D_FF, D_MODEL), D_FF ** -0.5),
        "ple_w_proj": n(ks[22], (L, PLE_DIM, D_MODEL), PLE_DIM ** -0.5),
        "ple_norm_g": gain(ks[23], (L, D_MODEL)),
        "ple_gate_norm_g": gain(ks[24], (L, D_MODEL)),
        "ple_w_gate": n(ks[25], (L, D_MODEL, D_MODEL), D_MODEL ** -0.5),
        "final_norm_g": gain(ks[26], (D_MODEL,)),
    }


def reference(x, p, mix_norm_g, w_in, conv_mix_w, rwkv_mu, rwkv_w0, rwkv_w_up, rwkv_a0,
              rwkv_a_up, rwkv_g_up, rwkv_k_k, rwkv_k_a, rwkv_r_k, rwkv_gn_w, rwkv_gn_b,
              w_out, ffn_norm_g, ffn_w_up, ffn_conv_w, ffn_conv_b, ffn_w_down,
              ple_w_proj, ple_norm_g, ple_gate_norm_g, ple_w_gate, final_norm_g):
    for i in range(DEPTH):
        h = rms_norm(x, mix_norm_g[i])
        z = h @ w_in[i]
        z_conv, z_rwkv = z[..., :3 * CONV_WIDTH], z[..., 3 * CONV_WIDTH:]
        y_conv = short_conv_mixer(z_conv, conv_mix_w[i])
        y_rwkv = rwkv7_mixer(z_rwkv, rwkv_mu[i], rwkv_w0[i], rwkv_w_up[i], rwkv_a0[i],
                             rwkv_a_up[i], rwkv_g_up[i], rwkv_k_k[i], rwkv_k_a[i],
                             rwkv_r_k[i], rwkv_gn_w[i], rwkv_gn_b[i])
        x = x + jnp.concatenate([y_conv, y_rwkv], axis=-1) @ w_out[i]
        x = x + conv_glu_ffn(rms_norm(x, ffn_norm_g[i]), ffn_w_up[i], ffn_conv_w[i],
                             ffn_conv_b[i], ffn_w_down[i])
        e = rms_norm(p[i] @ ple_w_proj[i], ple_norm_g[i])
        gate = jax.nn.sigmoid(rms_norm(x, ple_gate_norm_g[i]) @ ple_w_gate[i])
        x = x + gate * e
    return rms_norm(x, final_norm_g)
```

```cpp
#include <hip/hip_runtime.h>
#include <hip/hip_cooperative_groups.h>
#include <cstdio>
#include <cstdint>
namespace cg = cooperative_groups;
namespace pg8 {
#define PG8_LAS __attribute__((address_space(3)))
typedef unsigned short bf16_t;
typedef short bf16x8 __attribute__((ext_vector_type(8)));
typedef float f32x4 __attribute__((ext_vector_type(4)));
typedef unsigned u32x4 __attribute__((ext_vector_type(4)));
constexpr int BM = 256, BK = 64, HALF = 128, HTB = HALF * BK * 2  , STAGE_BYTES = 8 * HTB, NXCD = 8, WGM = 8;

__host__ __device__ __forceinline__ int lds_byte(int r, int c) { const int st = (r >> 4) * 2 + (c >> 5), rr = r & 15, cc = c & 31, ob = rr * 64 + cc * 2; return st * 1024 + (ob ^ (((ob >> 9) & 1) << 5)); }
__host__ __device__ __forceinline__ void stage_rc(int b, int& R, int& C) { const int st = b / 1024, sb = b % 1024, swz = sb ^ (((sb >> 9) & 1) << 5); R = (st >> 1) * 16 + swz / 64; C = (st & 1) * 32 + (swz % 64) / 2; }
__host__ __device__ __forceinline__ int perm32(int rho) { const int n = rho >> 4, i = rho & 15; return 8 * (i >> 2) + 4 * n + (i & 3); }

struct Unit { int pm, pn; };
struct Gemm { const bf16_t* A; const bf16_t* Bt; int M, N, K; };

struct StaticOrder {
    int nM, nN, nwg, G, c;
    __host__ __device__ void init(int M, int N, int G_, int c_) { nM = M / BM; nN = N / BM; nwg = nM * nN; G = G_; c = c_; }
    __host__ __device__ bool next(int i, Unit& u) const {
        const long L = (long)i * G + c; if (L >= nwg) return false;
        int wgid = (int)L; { const int q = nwg / NXCD, r = nwg % NXCD, xcd = wgid % NXCD, off = wgid / NXCD; wgid = (xcd < r ? xcd * (q + 1) : r * (q + 1) + (xcd - r) * q) + off; }
        const int nig = WGM * nN, gid = wgid / nig, fm = gid * WGM, gsz = (nM - fm) < WGM ? (nM - fm) : WGM;
        u.pm = fm + ((wgid % nig) % gsz); u.pn = (wgid % nig) / gsz; return true;
    }
    __device__ __forceinline__ void a_ready(const Unit&) const {}
    __device__ __forceinline__ void done(const Unit&) const {}
};
__device__ __forceinline__ unsigned cvt_pk_bf16(float lo, float hi) { unsigned r; asm volatile("s_nop 0\n\tv_cvt_pk_bf16_f32 %0, %1, %2" : "=v"(r) : "v"(lo), "v"(hi)); return r; }
template <class Epi, class Sched, bool ALIGN_EPI = false, bool SP2 = false>
__device__ __forceinline__ void gemm_phase(PG8_LAS unsigned char* lds, const Gemm g, const Sched& S, const Epi& E) {
    int tid_ = threadIdx.x; asm volatile("" : "+v"(tid_));
    const int tid = tid_, wid = __builtin_amdgcn_readfirstlane(tid >> 6), lane = tid & 63, wr = wid >> 2, wc = wid & 3, fr = lane & 15, fq = lane >> 4;
    const int K = g.K, nt = K / BK;
    unsigned voffA[2], voffB[2];
#pragma unroll
    for (int i = 0; i < 2; ++i) { int R, C; stage_rc(tid * 16 + i * 8192, R, C); const int Rb = Epi::PERM ? ((R & ~31) + perm32(R & 31)) : R;
        voffA[i] = (unsigned)(R * K + C) * 2u; voffB[i] = (unsigned)(Rb * K + C) * 2u; }
    const size_t kstep = (size_t)(BK * 2);
    const size_t hstep = (size_t)HALF * K * 2;
    const size_t tstep = 2 * hstep;
    const unsigned ldsw = (unsigned)wid * 1024u;
    const int aoff = lds_byte(wr * 64 + fr, fq * 8), boff = lds_byte(wc * 32 + fr, fq * 8);
#define PG8_SA(b, h) (((b) * 2 + (h)) * HTB)
#define PG8_SB(b, h) ((4 + (b) * 2 + (h)) * HTB)
#define PG8_STAGE(bufoff, gbase, voff) do { _Pragma("unroll") for (int _i = 0; _i < 2; ++_i) \
        __builtin_amdgcn_global_load_lds((const unsigned*)((const char*)(gbase) + (voff)[_i]), (PG8_LAS unsigned*)(lds + (bufoff) + ldsw + _i * 8192), 16, 0, 0); } while (0)
#define PG8_LDA(dst, b, h) do { _Pragma("unroll") for (int m = 0; m < 4; ++m) _Pragma("unroll") for (int k = 0; k < 2; ++k) dst[m][k] = *(const PG8_LAS bf16x8*)(lds + PG8_SA(b, h) + aoff + m * 2048 + k * 1024); } while (0)
#define PG8_LDB(dst, b, h) do { _Pragma("unroll") for (int n = 0; n < 2; ++n) _Pragma("unroll") for (int k = 0; k < 2; ++k) dst[n][k] = *(const PG8_LAS bf16x8*)(lds + PG8_SB(b, h) + boff + n * 2048 + k * 1024); } while (0)
#define PG8_MMA(ai, bj, At, Bt) do { __builtin_amdgcn_s_setprio(1); _Pragma("unroll") for (int m = 0; m < 4; ++m) _Pragma("unroll") for (int n = 0; n < 2; ++n) _Pragma("unroll") for (int k = 0; k < 2; ++k) \
        acc[ai][bj][m][n] = __builtin_amdgcn_mfma_f32_16x16x32_bf16(Bt[n][k], At[m][k], acc[ai][bj][m][n], 0, 0, 0); __builtin_amdgcn_s_setprio(0); } while (0)
#define PG8_WAIT_V(n) asm volatile("s_waitcnt vmcnt(" #n ")" ::: "memory")
#define PG8_WAIT_L(n) asm volatile("s_waitcnt lgkmcnt(" #n ")" ::: "memory")
#define PG8_BAR __builtin_amdgcn_s_barrier()
#define PG8_SCHED __builtin_amdgcn_sched_barrier(0)
    Unit cur, nxt; int ui = 0;
    if (!S.next(0, cur)) return;
    f32x4 acc[2][2][4][2];
#pragma unroll
    for (int a = 0; a < 2; ++a)
#pragma unroll
        for (int b = 0; b < 2; ++b)
#pragma unroll
            for (int m = 0; m < 4; ++m)
#pragma unroll
                for (int n = 0; n < 2; ++n) acc[a][b][m][n] = (f32x4){0.f, 0.f, 0.f, 0.f};
    bf16x8 At[4][2], B0[2][2], B1[2][2];
    const char* cA = (const char*)g.A + (size_t)cur.pm * tstep; const char* cB = (const char*)g.Bt + (size_t)cur.pn * tstep;
    S.a_ready(cur);
    if constexpr (SP2) {
        PG8_STAGE(PG8_SB(0, 0), cB, voffB); PG8_STAGE(PG8_SB(0, 1), cB + hstep, voffB); PG8_STAGE(PG8_SA(0, 0), cA, voffA); PG8_STAGE(PG8_SA(0, 1), cA + hstep, voffA);
        if (wr == 1) PG8_BAR;
        PG8_WAIT_V(2); PG8_BAR;
        PG8_STAGE(PG8_SB(1, 0), cB + kstep, voffB); PG8_STAGE(PG8_SA(1, 0), cA + kstep, voffA); PG8_STAGE(PG8_SB(1, 1), cB + hstep + kstep, voffB);
        PG8_WAIT_V(6); PG8_BAR;
    } else {
        PG8_STAGE(PG8_SB(0, 0), cB, voffB); PG8_STAGE(PG8_SA(0, 0), cA, voffA); PG8_STAGE(PG8_SB(0, 1), cB + hstep, voffB); PG8_STAGE(PG8_SA(0, 1), cA + hstep, voffA);
        if (wr == 1) PG8_BAR;
        PG8_WAIT_V(4); PG8_BAR;
        PG8_STAGE(PG8_SB(1, 0), cB + kstep, voffB); PG8_STAGE(PG8_SA(1, 0), cA + kstep, voffA); PG8_STAGE(PG8_SB(1, 1), cB + hstep + kstep, voffB);
        PG8_WAIT_V(6); PG8_BAR;
    }
    for (;;) {
        const bool has_next = S.next(ui + 1, nxt);
        const char* nA = has_next ? (const char*)g.A + (size_t)nxt.pm * tstep : cA; const char* nB = has_next ? (const char*)g.Bt + (size_t)nxt.pn * tstep : cB;
        for (int t = 0; t < nt; t += 2) {
            const bool last = (t == nt - 2);
            const char* a1 = cA + (size_t)(t + 1) * kstep;
            const char* a2 = last ? nA : cA + (size_t)(t + 2) * kstep; const char* b2 = last ? nB : cB + (size_t)(t + 2) * kstep;
            const char* a3 = a2 + kstep; const char* b3 = b2 + kstep;
            if (last && has_next) S.a_ready(nxt);
            if constexpr (SP2) {
            PG8_LDB(B0, 0, 0); PG8_LDB(B1, 0, 1); PG8_SCHED; PG8_LDA(At, 0, 0); PG8_STAGE(PG8_SA(1, 1), a1 + hstep, voffA);
            PG8_WAIT_V(8); PG8_WAIT_L(0); PG8_BAR; PG8_MMA(0, 0, At, B0); PG8_MMA(0, 1, At, B1); PG8_BAR; PG8_SCHED;
            PG8_LDA(At, 0, 1); PG8_STAGE(PG8_SB(0, 0), b2, voffB); PG8_STAGE(PG8_SB(0, 1), b2 + hstep, voffB); PG8_STAGE(PG8_SA(0, 0), a2, voffA);
            PG8_WAIT_V(8); PG8_WAIT_L(0); PG8_BAR; PG8_MMA(1, 0, At, B0); PG8_MMA(1, 1, At, B1); PG8_BAR; PG8_SCHED;
            PG8_LDB(B0, 1, 0); PG8_LDB(B1, 1, 1); PG8_SCHED; PG8_LDA(At, 1, 0); PG8_STAGE(PG8_SA(0, 1), a2 + hstep, voffA);
            PG8_WAIT_V(8); PG8_WAIT_L(0); PG8_BAR; PG8_MMA(0, 0, At, B0); PG8_MMA(0, 1, At, B1); PG8_BAR; PG8_SCHED;
            PG8_LDA(At, 1, 1); PG8_STAGE(PG8_SB(1, 0), b3, voffB); PG8_STAGE(PG8_SB(1, 1), b3 + hstep, voffB); PG8_STAGE(PG8_SA(1, 0), a3, voffA);
            PG8_WAIT_V(8); PG8_WAIT_L(0); PG8_BAR; PG8_MMA(1, 0, At, B0); PG8_MMA(1, 1, At, B1); PG8_BAR; PG8_SCHED;
            } else {
            PG8_LDB(B0, 0, 0); PG8_SCHED; PG8_LDA(At, 0, 0); PG8_STAGE(PG8_SA(1, 1), a1 + hstep, voffA);
            PG8_WAIT_L(8); PG8_BAR; PG8_WAIT_L(0); PG8_MMA(0, 0, At, B0); PG8_BAR; PG8_SCHED;
            PG8_LDB(B1, 0, 1); PG8_STAGE(PG8_SB(0, 0), b2, voffB);
            PG8_BAR; PG8_WAIT_L(0); PG8_MMA(0, 1, At, B1); PG8_BAR;
            PG8_LDA(At, 0, 1); PG8_STAGE(PG8_SA(0, 0), a2, voffA);
            PG8_BAR; PG8_WAIT_L(0); PG8_MMA(1, 0, At, B0); PG8_BAR; PG8_SCHED;
            PG8_STAGE(PG8_SB(0, 1), b2 + hstep, voffB);
            PG8_WAIT_V(6); PG8_BAR; PG8_MMA(1, 1, At, B1); PG8_BAR;
            PG8_LDB(B0, 1, 0); PG8_SCHED; PG8_LDA(At, 1, 0); PG8_STAGE(PG8_SA(0, 1), a2 + hstep, voffA);
            PG8_WAIT_L(8); PG8_BAR; PG8_WAIT_L(0); PG8_MMA(0, 0, At, B0); PG8_BAR; PG8_SCHED;
            PG8_LDB(B1, 1, 1); PG8_STAGE(PG8_SB(1, 0), b3, voffB);
            PG8_BAR; PG8_WAIT_L(0); PG8_MMA(0, 1, At, B1); PG8_BAR;
            PG8_LDA(At, 1, 1); PG8_STAGE(PG8_SA(1, 0), a3, voffA);
            PG8_BAR; PG8_WAIT_L(0); PG8_MMA(1, 0, At, B0); PG8_BAR; PG8_SCHED;
            PG8_STAGE(PG8_SB(1, 1), b3 + hstep, voffB);
            PG8_WAIT_V(6); PG8_BAR; PG8_MMA(1, 1, At, B1); PG8_BAR;
            }
        }
        if constexpr (ALIGN_EPI) { if (wr == 0) PG8_BAR; }
        if constexpr (!Epi::AFTER_DRAIN) { E(acc, cur, wr, wc, fr, fq); S.done(cur); }
        if (!has_next) break;
#pragma unroll
        for (int a = 0; a < 2; ++a)
#pragma unroll
            for (int b = 0; b < 2; ++b)
#pragma unroll
                for (int m = 0; m < 4; ++m)
#pragma unroll
                    for (int n = 0; n < 2; ++n) acc[a][b][m][n] = (f32x4){0.f, 0.f, 0.f, 0.f};
        cur = nxt; cA = nA; cB = nB; ++ui;
        if constexpr (ALIGN_EPI) { if (wr == 1) PG8_BAR; }
    }
    PG8_WAIT_V(0);
    if constexpr (!ALIGN_EPI) { if (wr == 0) PG8_BAR; }
    PG8_BAR;
    if constexpr (Epi::AFTER_DRAIN) { E.fused(acc, cur, wr, wc, fr, fq, lds, wid, lane); S.done(cur); }
#undef PG8_SA
#undef PG8_SB
#undef PG8_STAGE
#undef PG8_LDA
#undef PG8_LDB
#undef PG8_MMA
#undef PG8_WAIT_V
#undef PG8_WAIT_L
#undef PG8_BAR
#undef PG8_SCHED
}
}

#define LAS __attribute__((address_space(3)))
typedef unsigned short bf16_t;
typedef float f32x4 __attribute__((ext_vector_type(4)));
using pg8::cvt_pk_bf16;

constexpr int NB = 16, SEQ = 2048, DM = 1024, MTOK = NB * SEQ;
constexpr int NZ = 3328, CWID = 512, RWID = 512, NHEAD = 8, DFF = 2816, NUP = 5632, PLE = 256, NLORA = 1536, KLORA = 256;
constexpr int ZC_R = 1536, ZC_K = 2048, ZC_V = 2560, ZC_L = 3072;
constexpr int MH = MTOK / 2;
constexpr float NORM_EPS = 1e-6f, GN_EPS = 64e-5f;
constexpr int LDS_BYTES = 147456;

constexpr size_t MiB = 1u << 20;
constexpr size_t WS_BAR = 768 * 1024;
constexpr size_t WS_SS = 0;
constexpr size_t WS_WIN = 1 * MiB, WS_WLORA = 8 * MiB, WS_WOUT = 9 * MiB, WS_WUP = 11 * MiB, WS_WDOWN = 22 * MiB, WS_WPROJ = 28 * MiB, WS_WGATE = 29 * MiB;
constexpr size_t WS_CB = 31 * MiB;
constexpr size_t WS_XB = 32 * MiB;
constexpr size_t WS_Z = 96 * MiB;
constexpr size_t WS_L = 304 * MiB;
constexpr size_t WS_DEC = 320 * MiB;
constexpr size_t WS_A = 384 * MiB;
constexpr size_t WS_G = 416 * MiB;
constexpr size_t WS_YCAT = 448 * MiB;
constexpr size_t WS_O = 352 * MiB;
constexpr size_t WS_ACT = 96 * MiB;
constexpr size_t WS_SB = 272 * MiB;
constexpr size_t WS_PB = 304 * MiB;
constexpr size_t WS_E = 384 * MiB;

struct Args { const float* in[27]; float* out; unsigned char* ws; };

__device__ __forceinline__ void unpack8(const uint4 u, float* f) {
    f[0] = __uint_as_float(u.x << 16); f[1] = __uint_as_float(u.x & 0xffff0000u);
    f[2] = __uint_as_float(u.y << 16); f[3] = __uint_as_float(u.y & 0xffff0000u);
    f[4] = __uint_as_float(u.z << 16); f[5] = __uint_as_float(u.z & 0xffff0000u);
    f[6] = __uint_as_float(u.w << 16); f[7] = __uint_as_float(u.w & 0xffff0000u);
}
__device__ __forceinline__ void unpack4(const uint2 u, float* f) {
    f[0] = __uint_as_float(u.x << 16); f[1] = __uint_as_float(u.x & 0xffff0000u);
    f[2] = __uint_as_float(u.y << 16); f[3] = __uint_as_float(u.y & 0xffff0000u);
}
__device__ __forceinline__ uint4 pack8(const float* f) {
    uint4 r; r.x = cvt_pk_bf16(f[0], f[1]); r.y = cvt_pk_bf16(f[2], f[3]); r.z = cvt_pk_bf16(f[4], f[5]); r.w = cvt_pk_bf16(f[6], f[7]); return r;
}
__device__ __forceinline__ float sigmoidf_(float x) { return __builtin_amdgcn_rcpf(1.0f + __expf(-x)); }
__device__ __forceinline__ float wave_sum(float v) {
#pragma unroll
    for (int o = 1; o < 64; o <<= 1) v += __shfl_xor(v, o);
    return v;
}
template <int CTRL> __device__ __forceinline__ float dppf(float x) { return __int_as_float(__builtin_amdgcn_update_dpp(0, __float_as_int(x), CTRL, 0xF, 0xF, true)); }
__device__ __forceinline__ float reduce16(float x) { x += dppf<0xB1>(x); x += dppf<0x4E>(x); x += dppf<0x124>(x); x += dppf<0x128>(x); return x; }

enum { MODE_Z = 0, MODE_LORA = 1, MODE_WOUT = 2, MODE_UP = 3, MODE_DOWN = 4, MODE_PLE = 5, MODE_GATE = 6 };
template <int MODE> struct Epi {
    static constexpr bool PERM = true, AFTER_DRAIN = false;
    int row_off;
    float* f0; const float* xin;
    bf16_t* b0; int ldb;
    const float* ssin; float* ssout;
    const float* c0; const float* c1;
    float* f1; bf16_t* b1; bf16_t* b2;
    const bf16_t* e0; const float* ssin2;
    float* sb;

    __device__ __forceinline__ void up_fused(const f32x4 (&acc)[2][2][4][2], const pg8::Unit& u, int wr, int wc, int fr, int fq) const {
        const int jcol = u.pn * 128 + wc * 32 + 8 * fq;
        float rsr[2][4];
#pragma unroll
        for (int ai = 0; ai < 2; ++ai)
#pragma unroll
            for (int m = 0; m < 4; ++m) rsr[ai][m] = rsqrtf(ssin[u.pm * 256 + ai * 128 + wr * 64 + m * 16 + fr] * (1.0f / DM) + NORM_EPS);
        if (fr < 2 || fr >= 14) {
            const int mm = fr < 2 ? 0 : 3, slot = fr < 2 ? fr : fr - 12;
#pragma unroll
            for (int ai = 0; ai < 2; ++ai) {
                const int g = u.pm * 4 + ai * 2 + wr;
                const float sc = fr < 2 ? rsr[ai][0] : rsr[ai][3];
#pragma unroll
                for (int bj = 0; bj < 2; ++bj) {
                    bf16_t* dst = (bf16_t*)sb + ((size_t)g * 4 + slot) * NUP + bj * DFF + jcol;
                    const f32x4 a0 = (fr < 2 ? acc[ai][bj][0][0] : acc[ai][bj][3][0]) * sc, a1 = (fr < 2 ? acc[ai][bj][0][1] : acc[ai][bj][3][1]) * sc;
                    uint4 o; o.x = cvt_pk_bf16(a0[0], a0[1]); o.y = cvt_pk_bf16(a0[2], a0[3]); o.z = cvt_pk_bf16(a1[0], a1[1]); o.w = cvt_pk_bf16(a1[2], a1[3]);
                    *(uint4*)dst = o;
                }
            }
            (void)mm;
        }
        unsigned outp[2][4][4];
        const bool ge1 = fr >= 1, ge2 = fr >= 2;
#pragma unroll
        for (int ip = 0; ip < 4; ++ip) {
            float actv[2][2][4];
#pragma unroll
            for (int ic = 0; ic < 2; ++ic) {
                const int i = 2 * ip + ic, n = i >> 2, e = i & 3;
                float cv[2][2][4];
#pragma unroll
                for (int bj = 0; bj < 2; ++bj) {
                    const int cc = bj * DFF + jcol + i;
                    const float w0 = c0[cc], w1 = c0[NUP + cc], w2 = c0[2 * NUP + cc], bb = c1[cc];
#pragma unroll
                    for (int ai = 0; ai < 2; ++ai) {
                        float r1p = 0.f, r2p = 0.f;
#pragma unroll
                        for (int m = 0; m < 4; ++m) {
                            const float X = acc[ai][bj][m][n][e] * rsr[ai][m];
                            const float r1 = dppf<0x121>(X), r2 = dppf<0x122>(X);
                            const float p1 = ge1 ? r1 : r1p, p2 = ge2 ? r2 : r2p;
                            cv[bj][ai][m] = w2 * X + (w1 * p1 + (w0 * p2 + bb));
                            r1p = r1; r2p = r2;
                        }
                    }
                }
#pragma unroll
                for (int ai = 0; ai < 2; ++ai)
#pragma unroll
                    for (int m = 0; m < 4; ++m) { const float gc = cv[0][ai][m]; actv[ic][ai][m] = gc * __builtin_amdgcn_rcpf(1.0f + __expf(-gc)) * cv[1][ai][m]; }
            }
#pragma unroll
            for (int ai = 0; ai < 2; ++ai)
#pragma unroll
                for (int m = 0; m < 4; ++m) outp[ai][m][ip] = cvt_pk_bf16(actv[0][ai][m], actv[1][ai][m]);
        }
#pragma unroll
        for (int ai = 0; ai < 2; ++ai)
#pragma unroll
            for (int m = 0; m < 4; ++m) {
                if (m == 0 && fr < 2) continue;
                const int row = u.pm * 256 + ai * 128 + wr * 64 + m * 16 + fr;
                uint4 o; o.x = outp[ai][m][0]; o.y = outp[ai][m][1]; o.z = outp[ai][m][2]; o.w = outp[ai][m][3];
                *(uint4*)(b0 + (size_t)row * DFF + jcol) = o;
            }
    }
    __device__ __forceinline__ void operator()(const f32x4 (&acc)[2][2][4][2], const pg8::Unit& u, int wr, int wc, int fr, int fq) const {
        if (MODE == MODE_UP) { up_fused(acc, u, wr, wc, fr, fq); return; }
        const int rowb = row_off + u.pm * 256 + wr * 64 + fr;
        const int colb = u.pn * 256 + wc * 32 + 8 * fq;
        float rs[2][4], rs2[2][4];
        if (MODE == MODE_Z || MODE == MODE_GATE) {
#pragma unroll
            for (int ai = 0; ai < 2; ++ai)
#pragma unroll
                for (int m = 0; m < 4; ++m) { rs[ai][m] = ssin[rowb + ai * 128 + m * 16]; if (MODE == MODE_GATE) rs2[ai][m] = ssin2[rowb + ai * 128 + m * 16]; }
#pragma unroll
            for (int ai = 0; ai < 2; ++ai)
#pragma unroll
                for (int m = 0; m < 4; ++m) { rs[ai][m] = rsqrtf(rs[ai][m] * (1.0f / DM) + NORM_EPS); if (MODE == MODE_GATE) rs2[ai][m] = rsqrtf(rs2[ai][m] * (1.0f / DM) + NORM_EPS); }
        }
        if (MODE == MODE_Z) {
#pragma unroll
            for (int ai = 0; ai < 2; ++ai)
#pragma unroll
                for (int m = 0; m < 4; ++m)
#pragma unroll
                    for (int bj = 0; bj < 2; ++bj) {
                        const f32x4 a = acc[ai][bj][m][0] * rs[ai][m], b = acc[ai][bj][m][1] * rs[ai][m];
                        uint4 o; o.x = cvt_pk_bf16(a[0], a[1]); o.y = cvt_pk_bf16(a[2], a[3]); o.z = cvt_pk_bf16(b[0], b[1]); o.w = cvt_pk_bf16(b[2], b[3]);
                        *(uint4*)(b0 + (size_t)(rowb + ai * 128 + m * 16) * ldb + colb + bj * 128) = o;
                    }
        } else if (MODE == MODE_LORA) {
#pragma unroll
            for (int ai = 0; ai < 2; ++ai)
#pragma unroll
                for (int m = 0; m < 4; ++m) {
                    const int row = rowb + ai * 128 + m * 16;
#pragma unroll
                    for (int bj = 0; bj < 2; ++bj) {
                        const int col = colb + bj * 128;
                        float v[8];
#pragma unroll
                        for (int i = 0; i < 4; ++i) { v[i] = acc[ai][bj][m][0][i]; v[4 + i] = acc[ai][bj][m][1][i]; }
                        if (u.pn < 2) *(uint4*)((bf16_t*)f1 + (size_t)row * 512 + col) = pack8(v);
                        else if (u.pn < 4) *(uint4*)(b1 + (size_t)row * 512 + col - 512) = pack8(v);
                        else *(uint4*)(b2 + (size_t)row * 512 + col - 1024) = pack8(v);
                    }
                }
        } else if (MODE == MODE_PLE) {
#pragma unroll
            for (int ai = 0; ai < 2; ++ai)
#pragma unroll
                for (int m = 0; m < 4; ++m) {
                    float ssacc = 0.f;
#pragma unroll
                    for (int bj = 0; bj < 2; ++bj) {
                        float v[8];
#pragma unroll
                        for (int i = 0; i < 4; ++i) { v[i] = acc[ai][bj][m][0][i]; v[4 + i] = acc[ai][bj][m][1][i]; }
#pragma unroll
                        for (int i = 0; i < 8; ++i) ssacc += v[i] * v[i];
                        *(uint4*)(b0 + (size_t)(rowb + ai * 128 + m * 16) * ldb + colb + bj * 128) = pack8(v);
                    }
                    ssacc += __shfl_xor(ssacc, 16); ssacc += __shfl_xor(ssacc, 32);
                    if (fq == 0) atomicAdd(ssout + rowb + ai * 128 + m * 16, ssacc);
                }
        } else if (MODE == MODE_WOUT || MODE == MODE_DOWN) {
#pragma unroll
            for (int ai = 0; ai < 2; ++ai) {
                f32x4 res[4][2][2];
                {
                    uint4 rb[4][2];
#pragma unroll
                    for (int m = 0; m < 4; ++m)
#pragma unroll
                        for (int bj = 0; bj < 2; ++bj) rb[m][bj] = *(const uint4*)(b0 + (size_t)(rowb + ai * 128 + m * 16) * ldb + colb + bj * 128);
#pragma unroll
                    for (int m = 0; m < 4; ++m)
#pragma unroll
                        for (int bj = 0; bj < 2; ++bj) { float t8[8]; unpack8(rb[m][bj], t8); res[m][bj][0] = (f32x4){t8[0], t8[1], t8[2], t8[3]}; res[m][bj][1] = (f32x4){t8[4], t8[5], t8[6], t8[7]}; }
                }
                float ssr[4];
#pragma unroll
                for (int m = 0; m < 4; ++m) {
                    float ssacc = 0.f;
#pragma unroll
                    for (int bj = 0; bj < 2; ++bj) {
                        const f32x4 a = acc[ai][bj][m][0] + res[m][bj][0], b = acc[ai][bj][m][1] + res[m][bj][1];
                        ssacc += (a[0] * a[0] + a[1] * a[1]) + (a[2] * a[2] + a[3] * a[3]) + (b[0] * b[0] + b[1] * b[1]) + (b[2] * b[2] + b[3] * b[3]);
                        uint4 o; o.x = cvt_pk_bf16(a[0], a[1]); o.y = cvt_pk_bf16(a[2], a[3]); o.z = cvt_pk_bf16(b[0], b[1]); o.w = cvt_pk_bf16(b[2], b[3]);
                        *(uint4*)(b0 + (size_t)(rowb + ai * 128 + m * 16) * ldb + colb + bj * 128) = o;
                    }
                    ssacc += __shfl_xor(ssacc, 16); ssacc += __shfl_xor(ssacc, 32); ssr[m] = ssacc;
                }
                if (fq == 0) {
#pragma unroll
                    for (int m = 0; m < 4; ++m) atomicAdd(ssout + rowb + ai * 128 + m * 16, ssr[m]);
                }
            }
        } else if (MODE == MODE_GATE) {
            float ssr[2][4];
#pragma unroll
            for (int ai = 0; ai < 2; ++ai)
#pragma unroll
                for (int m = 0; m < 4; ++m) ssr[ai][m] = 0.f;
#pragma unroll
            for (int bj = 0; bj < 2; ++bj) {
                const f32x4 ca = *(const f32x4*)(c0 + colb + bj * 128), cb = *(const f32x4*)(c0 + colb + bj * 128 + 4);
#pragma unroll
                for (int ai = 0; ai < 2; ++ai)
#pragma unroll
                    for (int mp = 0; mp < 2; ++mp) {
                        f32x4 res[2][2]; uint4 eb[2], xr[2];
#pragma unroll
                        for (int mm = 0; mm < 2; ++mm) {
                            const size_t off = (size_t)(rowb + ai * 128 + (2 * mp + mm) * 16) * DM + colb + bj * 128;
                            xr[mm] = *(const uint4*)(b0 + off); eb[mm] = *(const uint4*)(e0 + off);
                        }
#pragma unroll
                        for (int mm = 0; mm < 2; ++mm) { float t8[8]; unpack8(xr[mm], t8); res[mm][0] = (f32x4){t8[0], t8[1], t8[2], t8[3]}; res[mm][1] = (f32x4){t8[4], t8[5], t8[6], t8[7]}; }
#pragma unroll
                        for (int mm = 0; mm < 2; ++mm) {
                            const int m = 2 * mp + mm;
                            float e8[8]; unpack8(eb[mm], e8);
                            f32x4 a, b;
#pragma unroll
                            for (int i = 0; i < 4; ++i) {
                                a[i] = res[mm][0][i] + sigmoidf_(acc[ai][bj][m][0][i] * rs[ai][m]) * (e8[i] * rs2[ai][m] * ca[i]);
                                b[i] = res[mm][1][i] + sigmoidf_(acc[ai][bj][m][1][i] * rs[ai][m]) * (e8[4 + i] * rs2[ai][m] * cb[i]);
                            }
                            ssr[ai][m] += (a[0] * a[0] + a[1] * a[1]) + (a[2] * a[2] + a[3] * a[3]) + (b[0] * b[0] + b[1] * b[1]) + (b[2] * b[2] + b[3] * b[3]);
                            const size_t off = (size_t)(rowb + ai * 128 + m * 16) * DM + colb + bj * 128;
                            uint4 o; o.x = cvt_pk_bf16(a[0], a[1]); o.y = cvt_pk_bf16(a[2], a[3]); o.z = cvt_pk_bf16(b[0], b[1]); o.w = cvt_pk_bf16(b[2], b[3]);
                            *(uint4*)(const_cast<bf16_t*>(e0) + off) = o;
                        }
                    }
            }
#pragma unroll
            for (int ai = 0; ai < 2; ++ai)
#pragma unroll
                for (int m = 0; m < 4; ++m) {
                    float t = ssr[ai][m]; t += __shfl_xor(t, 16); t += __shfl_xor(t, 32);
                    if (fq == 0) atomicAdd(ssout + rowb + ai * 128 + m * 16, t);
                }
        }
    }
};

template <bool UPMAP> __device__ __forceinline__ void p0_transpose_item(const float* W, int K, int N, bf16_t* WT, const float* gain, LAS float* scr, int item, int lane, int ldw = 0) {
    if (ldw == 0) ldw = K;
    const int nblk = N / 32, kb = item / nblk, nb = item % nblk, k0 = 64 * kb, n0 = 32 * nb;
    const int p = lane >> 5, l31 = lane & 31, c = lane & 7;
    float r[32];
#pragma unroll
    for (int i = 0; i < 32; ++i) r[i] = W[(size_t)(k0 + 2 * i + p) * N + n0 + l31];
    f32x4 ga = (f32x4){1.f, 1.f, 1.f, 1.f}, gb = ga;
    if (gain) { ga = *(const f32x4*)(gain + k0 + 8 * c); gb = *(const f32x4*)(gain + k0 + 8 * c + 4); }
#pragma unroll
    for (int i = 0; i < 32; ++i) scr[(2 * i + p) * 33 + l31] = r[i];
    asm volatile("s_waitcnt lgkmcnt(0)" ::: "memory");
#pragma unroll
    for (int j = 0; j < 4; ++j) { const int n = (lane >> 3) + 8 * j; const LAS float* s = scr + (8 * c) * 33 + n;
        uint4 o; o.x = cvt_pk_bf16(s[0 * 33] * ga[0], s[1 * 33] * ga[1]); o.y = cvt_pk_bf16(s[2 * 33] * ga[2], s[3 * 33] * ga[3]); o.z = cvt_pk_bf16(s[4 * 33] * gb[0], s[5 * 33] * gb[1]); o.w = cvt_pk_bf16(s[6 * 33] * gb[2], s[7 * 33] * gb[3]);
        int nd = n0 + n; if (UPMAP) { const int hv = nd >= DFF ? 1 : 0, mloc = nd - hv * DFF; nd = (mloc >> 7) * 256 + hv * 128 + (mloc & 127); }
        *(uint4*)(WT + (size_t)nd * ldw + k0 + 8 * c) = o; }
    asm volatile("s_waitcnt lgkmcnt(0)" ::: "memory");
}

template <bool UPMAP> __device__ __forceinline__ void transpose_half_item(const float* W, int K, int N, bf16_t* WT, const float* gain, LAS float* scr, int item, int lane) {
    const int nblk = N / 32, kb = item / nblk, nb = item % nblk, k0 = 32 * kb, n0 = 32 * nb;
    const int p = lane >> 5, l31 = lane & 31, c = lane & 3;
    float r[16];
#pragma unroll
    for (int i = 0; i < 16; ++i) r[i] = W[(size_t)(k0 + 2 * i + p) * N + n0 + l31];
    f32x4 ga = (f32x4){1.f, 1.f, 1.f, 1.f}, gb = ga;
    if (gain) { ga = *(const f32x4*)(gain + k0 + 8 * c); gb = *(const f32x4*)(gain + k0 + 8 * c + 4); }
#pragma unroll
    for (int i = 0; i < 16; ++i) scr[(2 * i + p) * 33 + l31] = r[i];
    asm volatile("s_waitcnt lgkmcnt(0)" ::: "memory");
#pragma unroll
    for (int j = 0; j < 2; ++j) { const int n = (lane >> 2) + 16 * j; const LAS float* s = scr + (8 * c) * 33 + n;
        uint4 o; o.x = cvt_pk_bf16(s[0 * 33] * ga[0], s[1 * 33] * ga[1]); o.y = cvt_pk_bf16(s[2 * 33] * ga[2], s[3 * 33] * ga[3]); o.z = cvt_pk_bf16(s[4 * 33] * gb[0], s[5 * 33] * gb[1]); o.w = cvt_pk_bf16(s[6 * 33] * gb[2], s[7 * 33] * gb[3]);
        int nd = n0 + n; if (UPMAP) { const int hv = nd >= DFF ? 1 : 0, mloc = nd - hv * DFF; nd = (mloc >> 7) * 256 + hv * 128 + (mloc & 127); }
        *(uint4*)(WT + (size_t)nd * K + k0 + 8 * c) = o; }
    asm volatile("s_waitcnt lgkmcnt(0)" ::: "memory");
}
constexpr int I_IN = (DM / 64) * (NZ / 32), I_OUT = (DM / 64) * (DM / 32), I_UP = (DM / 64) * (NUP / 32), I_DOWN = (DFF / 64) * (DM / 32), I_PROJ = (PLE / 64) * (DM / 32), I_GATE = I_OUT;
constexpr int I_LW = 16, I_LA = 16, I_LG = 32;
constexpr int N_EARLY = I_IN + I_LW + I_LA + I_LG, N_LATE = 2 * (I_OUT + I_UP + I_DOWN + I_PROJ + I_GATE);
constexpr size_t WS_PTAB = 832 * 1024;
__device__ __forceinline__ void late_weight_item(unsigned char* ws, LAS float* scr, int r, int lane) {
    const float* const* tab = (const float* const*)(ws + WS_PTAB);
    if (r < 2 * I_OUT) { transpose_half_item<false>(tab[0], DM, DM, (bf16_t*)(ws + WS_WOUT), nullptr, scr, r, lane); return; } r -= 2 * I_OUT;
    if (r < 2 * I_UP) { transpose_half_item<true>(tab[1], DM, NUP, (bf16_t*)(ws + WS_WUP), tab[2], scr, r, lane); return; } r -= 2 * I_UP;
    if (r < 2 * I_DOWN) { transpose_half_item<false>(tab[3], DFF, DM, (bf16_t*)(ws + WS_WDOWN), nullptr, scr, r, lane); return; } r -= 2 * I_DOWN;
    if (r < 2 * I_PROJ) { transpose_half_item<false>(tab[4], PLE, DM, (bf16_t*)(ws + WS_WPROJ), nullptr, scr, r, lane); return; } r -= 2 * I_PROJ;
    transpose_half_item<false>(tab[5], DM, DM, (bf16_t*)(ws + WS_WGATE), tab[6], scr, r, lane);
}
__device__ __forceinline__ void phase0(const Args& A, LAS unsigned char* lds, int tid, int lane, int wave) {
    unsigned char* ws = A.ws;
    LAS float* scr = (LAS float*)(lds + wave * 16384);
    const int gw = blockIdx.x * 8 + wave, NGW = gridDim.x * 8;
    for (int it = gw; it < N_EARLY; it += NGW) {
        int r = it;
        if (r < I_IN) { p0_transpose_item<false>(A.in[3], DM, NZ, (bf16_t*)(ws + WS_WIN), A.in[2], scr, r, lane); continue; } r -= I_IN;
        bf16_t* WLp = (bf16_t*)(ws + WS_WLORA);
        if (r < I_LW) { p0_transpose_item<false>(A.in[7], 64, 512, WLp, nullptr, scr, r, lane, KLORA); continue; } r -= I_LW;
        if (r < I_LA) { p0_transpose_item<false>(A.in[9], 64, 512, WLp + (size_t)512 * KLORA + 64, nullptr, scr, r, lane, KLORA); continue; } r -= I_LA;
        p0_transpose_item<false>(A.in[10], 128, 512, WLp + (size_t)1024 * KLORA + 128, nullptr, scr, r, lane, KLORA);
    }
    {
        bf16_t* WL = (bf16_t*)(ws + WS_WLORA);
        const int gt = blockIdx.x * 512 + tid, NT = gridDim.x * 512;
        for (int ci = gt; ci < NLORA * (KLORA / 8); ci += NT) {
            const int n = ci / (KLORA / 8), k = (ci % (KLORA / 8)) * 8;
            const bool diag = n < 512 ? (k < 64) : (n < 1024 ? (k >= 64 && k < 128) : (k >= 128));
            if (!diag) *(uint4*)(WL + (size_t)n * KLORA + k) = make_uint4(0, 0, 0, 0);
        }
        float* ss = (float*)(ws + WS_SS);
        for (int i = gt; i < 4 * MTOK; i += NT) ss[MTOK + i] = 0.f;
    }
    if (blockIdx.x == 0) { unsigned* bw = (unsigned*)(ws + WS_BAR); for (int i = tid; i < 4096; i += 512) bw[i] = 0u; }
    if (blockIdx.x == 0 && tid == 0) { const float** tab = (const float**)(ws + WS_PTAB); tab[0] = A.in[16]; tab[1] = A.in[18]; tab[2] = A.in[17]; tab[3] = A.in[21]; tab[4] = A.in[22]; tab[5] = A.in[25]; tab[6] = A.in[24]; tab[7] = A.in[4]; }
    {
        const float* x = A.in[0]; bf16_t* xb = (bf16_t*)(ws + WS_XB); float* ss1 = (float*)(ws + WS_SS);
        for (int m0 = gw; m0 < MTOK; m0 += 4 * NGW) {
            f32x4 v[4][4];
#pragma unroll
            for (int r = 0; r < 4; ++r) {
                const int m = (m0 + r * NGW < MTOK) ? m0 + r * NGW : m0;
                const f32x4* xr = (const f32x4*)(x + (size_t)m * DM) + lane;
#pragma unroll
                for (int j = 0; j < 4; ++j) v[r][j] = xr[64 * j];
            }
#pragma unroll
            for (int r = 0; r < 4; ++r) {
                const int m = m0 + r * NGW;
                float s_ = 0.f;
#pragma unroll
                for (int j = 0; j < 4; ++j) s_ += (v[r][j].x * v[r][j].x + v[r][j].y * v[r][j].y) + (v[r][j].z * v[r][j].z + v[r][j].w * v[r][j].w);
                s_ = wave_sum(s_);
                if (m < MTOK) {
                    if (lane == 0) ss1[m] = s_;
                    uint2* o8 = (uint2*)(xb + (size_t)m * DM) + lane;
#pragma unroll
                    for (int j = 0; j < 4; ++j) { uint2 o; o.x = cvt_pk_bf16(v[r][j].x, v[r][j].y); o.y = cvt_pk_bf16(v[r][j].z, v[r][j].w); o8[64 * j] = o; }
                }
            }
        }
    }
}

__device__ __forceinline__ void phase2(const Args& A, int lane, int wave) {
    unsigned char* ws = A.ws;
    const bf16_t* z = (const bf16_t*)(ws + WS_Z); bf16_t* L = (bf16_t*)(ws + WS_L);
    const float* mu = A.in[5];
    const int gw = blockIdx.x * 8 + wave, NGW = gridDim.x * 8;
    const int hl = lane >> 5, l32 = lane & 31, c = 8 * l32;
    float mu8[8];
#pragma unroll
    for (int i = 0; i < 8; ++i) mu8[i] = mu[1536 + c + i];
    for (int strip = gw; strip < MTOK / 16; strip += NGW) {
        const int row0 = strip * 16;
#pragma unroll
        for (int i4 = 0; i4 < 16; i4 += 8) {
            uint4 zc[4], zp[4];
#pragma unroll
            for (int r = 0; r < 4; ++r) {
                const int row = row0 + i4 + 2 * r + hl;
                zc[r] = *(const uint4*)(z + (size_t)row * NZ + ZC_L + c);
                zp[r] = ((row & (SEQ - 1)) != 0) ? *(const uint4*)(z + (size_t)(row - 1) * NZ + ZC_L + c) : make_uint4(0, 0, 0, 0);
            }
#pragma unroll
            for (int r = 0; r < 4; ++r) {
                const size_t row = (size_t)(row0 + i4 + 2 * r + hl);
                float a[8], p[8], o[8]; unpack8(zc[r], a); unpack8(zp[r], p);
#pragma unroll
                for (int j = 0; j < 8; ++j) { const float v = a[j] + (p[j] - a[j]) * mu8[j]; o[j] = (l32 < 8) ? tanhf(v) : ((l32 < 16) ? v : sigmoidf_(v)); }
                *(uint4*)(L + row * KLORA + c) = pack8(o);
            }
        }
    }
}

constexpr int TC = 32;
constexpr int SC_VEC = TC * 64;
constexpr int SC_BUF = 5 * SC_VEC + TC * 32;
struct ScanRegs { uint2 rc, rp, kc, kp, ac, dec; unsigned vc, vp; };
__device__ __forceinline__ void scan_load(ScanRegs& R, const bf16_t* z, const bf16_t* abuf, const bf16_t* dec, int b, int h, int half, int chunk, int tl, int kq) {
    const int t = chunk * TC + tl; const size_t row = (size_t)b * SEQ + t;
    const bf16_t* zr = z + row * NZ;
    R.rc = *(const uint2*)(zr + ZC_R + h * 64 + 4 * kq); R.kc = *(const uint2*)(zr + ZC_K + h * 64 + 4 * kq);
    R.vc = *(const unsigned*)(zr + ZC_V + h * 64 + 32 * half + 2 * kq);
    if (t > 0) { R.rp = *(const uint2*)(zr - NZ + ZC_R + h * 64 + 4 * kq); R.kp = *(const uint2*)(zr - NZ + ZC_K + h * 64 + 4 * kq); R.vp = *(const unsigned*)(zr - NZ + ZC_V + h * 64 + 32 * half + 2 * kq); }
    else { R.rp = make_uint2(0, 0); R.kp = make_uint2(0, 0); R.vp = 0u; }
    R.ac = *(const uint2*)(abuf + row * 512 + h * 64 + 4 * kq);
    R.dec = *(const uint2*)(dec + row * 512 + h * 64 + 4 * kq);
}
__device__ __forceinline__ void scan_store(const ScanRegs& R, LAS float* buf, const float* mu, const float* k_k, const float* k_a, const float* r_k, const float* w0, const float* a0, float* cbrow, int h, int half, int tl, int kq) {
    float rc[4], rp[4], kc[4], kp[4], a[4];
    unpack4(R.rc, rc); unpack4(R.rp, rp); unpack4(R.kc, kc); unpack4(R.kp, kp); unpack4(R.ac, a);
    const int ch = h * 64 + 4 * kq;
    const f32x4 mur = *(const f32x4*)(mu + ch), muk = *(const f32x4*)(mu + 512 + ch), kk4 = *(const f32x4*)(k_k + ch), ka4 = *(const f32x4*)(k_a + ch);
    {
        const f32x4 a04 = *(const f32x4*)(a0 + ch);
#pragma unroll
        for (int i = 0; i < 4; ++i) a[i] = sigmoidf_(a[i] + a04[i]);
    }
    float r[4], k[4], kk[4]; float ss = 0.f;
#pragma unroll
    for (int i = 0; i < 4; ++i) { r[i] = rc[i] + (rp[i] - rc[i]) * mur[i]; k[i] = kc[i] + (kp[i] - kc[i]) * muk[i]; kk[i] = k[i] * kk4[i]; ss += kk[i] * kk[i]; }
    ss = reduce16(ss);
    const float rn = rsqrtf(fmaxf(ss, 1e-24f));
    f32x4 nkk, kka, kpr, rr;
#pragma unroll
    for (int i = 0; i < 4; ++i) { const float kn = kk[i] * rn; nkk[i] = -kn; kka[i] = kn * a[i]; kpr[i] = k[i] * (1.0f + (a[i] - 1.0f) * ka4[i]); rr[i] = r[i]; }
    {
        const f32x4 rk4 = *(const f32x4*)(r_k + ch);
        float cbp = (r[0] * kpr[0] * rk4[0] + r[1] * kpr[1] * rk4[1]) + (r[2] * kpr[2] * rk4[2] + r[3] * kpr[3] * rk4[3]);
        cbp = reduce16(cbp);
        if (half == 0 && kq == 0) cbrow[(size_t)tl * 8] = cbp;
    }
    const int o = tl * 64 + 4 * kq;
    {
        float e4[4]; unpack4(R.dec, e4); const f32x4 w04 = *(const f32x4*)(w0 + ch);
        f32x4 wv;
#pragma unroll
        for (int i = 0; i < 4; ++i) wv[i] = __expf(-0.60653065971f * sigmoidf_(e4[i] + w04[i]));
        *(LAS f32x4*)(buf + o) = wv;
    }
    *(LAS f32x4*)(buf + SC_VEC + o) = nkk; *(LAS f32x4*)(buf + 2 * SC_VEC + o) = kka; *(LAS f32x4*)(buf + 3 * SC_VEC + o) = kpr; *(LAS f32x4*)(buf + 4 * SC_VEC + o) = rr;
    const int vch = h * 64 + 32 * half + 2 * kq;
    const float v0c = __uint_as_float(R.vc << 16), v1c = __uint_as_float(R.vc & 0xffff0000u), v0p = __uint_as_float(R.vp << 16), v1p = __uint_as_float(R.vp & 0xffff0000u);
    const float m0 = mu[1024 + vch], m1 = mu[1024 + vch + 1];
    buf[5 * SC_VEC + tl * 32 + 2 * kq] = v0c + (v0p - v0c) * m0; buf[5 * SC_VEC + tl * 32 + 2 * kq + 1] = v1c + (v1p - v1c) * m1;
}
struct StepVec { f32x4 w0, w1, a0, a1, k0, k1, r0, r1; float vv; };
struct StepN { f32x4 n0, n1; };
__device__ __forceinline__ void sv_load(StepVec& V, const LAS float* pk, const LAS float* pv, int t) {
    const LAS float* p = pk + t * 64;
    V.a0 = *(const LAS f32x4*)(p + 2 * SC_VEC); V.a1 = *(const LAS f32x4*)(p + 2 * SC_VEC + 4);
    V.k0 = *(const LAS f32x4*)(p + 3 * SC_VEC); V.k1 = *(const LAS f32x4*)(p + 3 * SC_VEC + 4);
    V.vv = pv[t * 32];
    V.w0 = *(const LAS f32x4*)(p); V.w1 = *(const LAS f32x4*)(p + 4);
    V.r0 = *(const LAS f32x4*)(p + 4 * SC_VEC); V.r1 = *(const LAS f32x4*)(p + 4 * SC_VEC + 4);
}
__device__ __forceinline__ void sn_load(StepN& N, const LAS float* pk, int t) {
    const LAS float* p = pk + t * 64 + SC_VEC;
    N.n0 = *(const LAS f32x4*)(p); N.n1 = *(const LAS f32x4*)(p + 4);
}
__device__ __forceinline__ float dot8(const f32x4& a, const f32x4& b, const f32x4& x, const f32x4& y) {
    float r = a.x * x.x; r = __builtin_fmaf(a.y, x.y, r); r = __builtin_fmaf(a.z, x.z, r); r = __builtin_fmaf(a.w, x.w, r);
    r = __builtin_fmaf(b.x, y.x, r); r = __builtin_fmaf(b.y, y.y, r); r = __builtin_fmaf(b.z, y.z, r); r = __builtin_fmaf(b.w, y.w, r); return r; }
__device__ __forceinline__ float reduce8(float x) { x += dppf<0xB1>(x); x += dppf<0x4E>(x); x += dppf<0x141>(x); return x; }
__device__ __forceinline__ void reduce8x2(float& x, float& y) { x += dppf<0xB1>(x); y += dppf<0xB1>(y); x += dppf<0x4E>(x); y += dppf<0x4E>(y); x += dppf<0x141>(x); y += dppf<0x141>(y); }
#define SCAN_STEP(CUR, NXT, NC, NN, T) do { \
        if ((T) + 2 < TC) sn_load(NC, pk, (T) + 2); \
        if ((T) + 1 < TC) sv_load(NXT, pk, pv, (T) + 1); \
        __builtin_amdgcn_sched_barrier(0);     \
        sA = sA * CUR.w0 + (CUR.a0 * sa + CUR.k0 * CUR.vv); sB = sB * CUR.w1 + (CUR.a1 * sa + CUR.k1 * CUR.vv); \
        float op_ = dot8(sA, sB, CUR.r0, CUR.r1); \
        if ((T) + 1 < TC) { float sp_ = dot8(sA, sB, NN.n0, NN.n1); reduce8x2(op_, sp_); sa = sp_; } else { op_ = reduce8(op_); } \
        oacc = (kq == ((T) & 7)) ? op_ : oacc; \
        if (((T) & 7) == 7) ost[((T) - 7 + kq) * 33 + row] = oacc; \
    } while (0)
__device__ __forceinline__ void scan_compute_chunk(f32x4& sA, f32x4& sB, const LAS float* buf, LAS float* ost, int row, int kq) {
    const LAS float* pk = buf + 8 * kq; const LAS float* pv = buf + 5 * SC_VEC + row;
    StepVec VA, VB; StepN N0, N1;
    sn_load(N0, pk, 0); sn_load(N1, pk, 1); sv_load(VA, pk, pv, 0);
    float sa = reduce8(dot8(sA, sB, N0.n0, N0.n1));
    float oacc = 0.f;
#pragma unroll
    for (int t2 = 0; t2 < TC / 2; ++t2) { SCAN_STEP(VA, VB, N0, N1, 2 * t2); SCAN_STEP(VB, VA, N1, N0, 2 * t2 + 1); }
}
__device__ __forceinline__ void scan_drain(const LAS float* ost, bf16_t* O, int b, int h, int half, int chunk, int ptid) {
    const int t = ptid >> 3, q = ptid & 7;
    const LAS float* p = ost + t * 33 + 4 * q;
    uint2 v; v.x = cvt_pk_bf16(p[0], p[1]); v.y = cvt_pk_bf16(p[2], p[3]);
    *(uint2*)(O + ((size_t)b * SEQ + chunk * TC + t) * 512 + h * 64 + 32 * half + 4 * q) = v;
}
struct YConv { f32x4 w0a, w0b, w1a, w1b, w2a, w2b, q1a, q1b, q2a, q2b; uint4 xq, bq, cq; int strip, row, end, pend; };
__device__ __forceinline__ void yconv_begin(YConv& Y, const bf16_t* z, const float* cwp, int lane) {
    const int c = 8 * lane;
    Y.w0a = *(const f32x4*)(cwp + c); Y.w0b = *(const f32x4*)(cwp + c + 4); Y.w1a = *(const f32x4*)(cwp + 512 + c); Y.w1b = *(const f32x4*)(cwp + 512 + c + 4);
    Y.w2a = *(const f32x4*)(cwp + 1024 + c); Y.w2b = *(const f32x4*)(cwp + 1024 + c + 4);
    Y.row = Y.strip * 32; Y.end = Y.row + 32;
    Y.q1a = (f32x4){0.f, 0.f, 0.f, 0.f}; Y.q1b = Y.q1a; Y.q2a = Y.q1a; Y.q2b = Y.q1a;
    if ((Y.row & (SEQ - 1)) != 0) {
        float xa[8], ca[8];
        unpack8(*(const uint4*)(z + (size_t)(Y.row - 1) * NZ + c), xa); unpack8(*(const uint4*)(z + (size_t)(Y.row - 1) * NZ + 1024 + c), ca);
        Y.q1a = (f32x4){xa[0] * ca[0], xa[1] * ca[1], xa[2] * ca[2], xa[3] * ca[3]}; Y.q1b = (f32x4){xa[4] * ca[4], xa[5] * ca[5], xa[6] * ca[6], xa[7] * ca[7]};
        unpack8(*(const uint4*)(z + (size_t)(Y.row - 2) * NZ + c), xa); unpack8(*(const uint4*)(z + (size_t)(Y.row - 2) * NZ + 1024 + c), ca);
        Y.q2a = (f32x4){xa[0] * ca[0], xa[1] * ca[1], xa[2] * ca[2], xa[3] * ca[3]}; Y.q2b = (f32x4){xa[4] * ca[4], xa[5] * ca[5], xa[6] * ca[6], xa[7] * ca[7]};
    }
}
__device__ __forceinline__ void yconv_issue(YConv& Y, const bf16_t* z, int lane) {
    const int c = 8 * lane; const bf16_t* zr = z + (size_t)Y.row * NZ;
    Y.xq = *(const uint4*)(zr + c); Y.bq = *(const uint4*)(zr + 512 + c); Y.cq = *(const uint4*)(zr + 1024 + c); Y.pend = 1;
}
__device__ __forceinline__ void yconv_finish(YConv& Y, bf16_t* ycat, int lane) {
    const int c = 8 * lane;
    float xa[8], ba[8], ca[8];
    unpack8(Y.xq, xa); unpack8(Y.bq, ba); unpack8(Y.cq, ca);
    const f32x4 qa = (f32x4){xa[0] * ca[0], xa[1] * ca[1], xa[2] * ca[2], xa[3] * ca[3]}, qb = (f32x4){xa[4] * ca[4], xa[5] * ca[5], xa[6] * ca[6], xa[7] * ca[7]};
    const f32x4 ya = (f32x4){ba[0], ba[1], ba[2], ba[3]} * (Y.w0a * Y.q2a + Y.w1a * Y.q1a + Y.w2a * qa), yb = (f32x4){ba[4], ba[5], ba[6], ba[7]} * (Y.w0b * Y.q2b + Y.w1b * Y.q1b + Y.w2b * qb);
    Y.q2a = Y.q1a; Y.q2b = Y.q1b; Y.q1a = qa; Y.q1b = qb;
    uint4 o; o.x = cvt_pk_bf16(ya[0], ya[1]); o.y = cvt_pk_bf16(ya[2], ya[3]); o.z = cvt_pk_bf16(yb[0], yb[1]); o.w = cvt_pk_bf16(yb[2], yb[3]);
    *(uint4*)(ycat + (size_t)Y.row * DM + c) = o;
    ++Y.row; Y.pend = 0;
}
#define SCAN_BAR() do { asm volatile("s_waitcnt lgkmcnt(0)" ::: "memory"); __builtin_amdgcn_s_barrier(); asm volatile("" ::: "memory"); } while (0)
__device__ __forceinline__ void phase3(const Args& A, LAS unsigned char* lds, int tid, int lane, int wave) {
    unsigned char* ws = A.ws;
    const bf16_t* z = (const bf16_t*)(ws + WS_Z); const bf16_t* abuf = (const bf16_t*)(ws + WS_A); const bf16_t* dec = (const bf16_t*)(ws + WS_DEC); bf16_t* O = (bf16_t*)(ws + WS_O);
    const float* mu = A.in[5]; const float* k_k = A.in[11]; const float* k_a = A.in[12]; const float* r_k = A.in[13]; float* CB = (float*)(ws + WS_CB); const float* w0p = A.in[6]; const float* a0p = A.in[8];
    LAS float* lbuf = (LAS float*)lds;
    LAS float* ostage = lbuf + 2 * SC_BUF;
    constexpr int NCH = SEQ / TC;
    int late_it = (wave >= 4) ? (int)blockIdx.x * 4 + (wave - 4) : N_LATE; const int late_stride = (int)gridDim.x * 4;
    for (int unit = blockIdx.x; unit < NB * NHEAD * 2; unit += gridDim.x) {
        const int bh = unit >> 1, half = unit & 1, b = bh >> 3, h = bh & 7;
        {
            ScanRegs R; scan_load(R, z, abuf, dec, b, h, half, 0, tid >> 4, tid & 15);
            scan_store(R, lbuf, mu, k_k, k_a, r_k, w0p, a0p, CB + ((size_t)b * SEQ) * 8 + h, h, half, tid >> 4, tid & 15);
        }
        if (wave < 4) {
            f32x4 sA = (f32x4){0.f, 0.f, 0.f, 0.f}, sB = sA;
            const int row = 8 * wave + (lane >> 3), kq = lane & 7;
            SCAN_BAR();
            for (int c = 0; c < NCH; ++c) {
                scan_compute_chunk(sA, sB, lbuf + (c & 1) * SC_BUF, ostage + (c & 1) * (32 * 33), row, kq);
                SCAN_BAR();
            }
        } else {
            const int ptid = tid - 256, tl = ptid >> 4, kq = ptid & 15;
            LAS float* wscr = lbuf + (2 * SC_BUF + 2 * 32 * 33) + (wave - 4) * (64 * 33);
            const float* cwp = ((const float* const*)(ws + WS_PTAB))[7]; bf16_t* ycat = (bf16_t*)(ws + WS_YCAT);
            YConv Y; Y.strip = unit * 4 + (wave - 4); Y.pend = 0; Y.xq = make_uint4(0, 0, 0, 0); Y.bq = Y.xq; Y.cq = Y.xq;
            yconv_begin(Y, z, cwp, lane);
            ScanRegs R0, R1;
            scan_load(R0, z, abuf, dec, b, h, half, 1, tl, kq); scan_load(R1, z, abuf, dec, b, h, half, 1, tl + 16, kq);
            SCAN_BAR();
            for (int c = 0; c < NCH; ++c) {
                if (c >= 33 && (c & 1) && late_it < N_LATE) { late_weight_item(ws, wscr, late_it, lane); late_it += late_stride; }
                if (Y.pend) yconv_finish(Y, ycat, lane);
                if (c >= 1) scan_drain(ostage + ((c - 1) & 1) * (32 * 33), O, b, h, half, c - 1, ptid);
                if (c + 1 < NCH) {
                    LAS float* nb = lbuf + ((c + 1) & 1) * SC_BUF;
                    float* cbr = CB + ((size_t)b * SEQ + (size_t)(c + 1) * TC) * 8 + h;
                    scan_store(R0, nb, mu, k_k, k_a, r_k, w0p, a0p, cbr, h, half, tl, kq); scan_store(R1, nb, mu, k_k, k_a, r_k, w0p, a0p, cbr, h, half, tl + 16, kq);
                    if (c + 2 < NCH) { scan_load(R0, z, abuf, dec, b, h, half, c + 2, tl, kq); scan_load(R1, z, abuf, dec, b, h, half, c + 2, tl + 16, kq); }
                }
                if (Y.row < Y.end) yconv_issue(Y, z, lane);
                SCAN_BAR();
            }
            scan_drain(ostage + ((NCH - 1) & 1) * (32 * 33), O, b, h, half, NCH - 1, ptid);
            while (Y.row < Y.end) { if (!Y.pend) yconv_issue(Y, z, lane); yconv_finish(Y, ycat, lane); }
        }
        __syncthreads();
    }
    if (wave >= 4) {
        LAS float* wscr = lbuf + (2 * SC_BUF + 2 * 32 * 33) + (wave - 4) * (64 * 33);
        for (; late_it < N_LATE; late_it += late_stride) late_weight_item(ws, wscr, late_it, lane);
    }
}

__device__ __forceinline__ void phase4(const Args& A, int lane, int wave) {
    unsigned char* ws = A.ws;
    const bf16_t* z = (const bf16_t*)(ws + WS_Z); const bf16_t* gbuf = (const bf16_t*)(ws + WS_G); const bf16_t* O = (const bf16_t*)(ws + WS_O); const float* CB = (const float*)(ws + WS_CB);
    bf16_t* ycat = (bf16_t*)(ws + WS_YCAT); bf16_t* pb = (bf16_t*)(ws + WS_PB);
    const float* mu = A.in[5]; const float* gn_w = A.in[14]; const float* gn_b = A.in[15]; const float* p = A.in[1];
    const int gw = blockIdx.x * 8 + wave, NGW = gridDim.x * 8;
    const int c = 8 * lane;
    for (int strip = gw; strip < MTOK / 16; strip += NGW) {
        const int row0 = strip * 16, t0 = row0 & (SEQ - 1);
        float muv[8], gw8[8], gb8[8];
#pragma unroll
        for (int i = 0; i < 8; ++i) { muv[i] = mu[1024 + c + i]; gw8[i] = gn_w[c + i]; gb8[i] = gn_b[c + i]; }
        uint4 vp = make_uint4(0, 0, 0, 0);
        if (t0 != 0) vp = *(const uint4*)(z + (size_t)(row0 - 1) * NZ + ZC_V + c);
        for (int i4 = 0; i4 < 16; i4 += 4) {
            uint4 vq[4], gq[4], oq[4]; float cbq[4]; f32x4 pq[4];
#pragma unroll
            for (int r = 0; r < 4; ++r) {
                const size_t row = (size_t)(row0 + i4 + r);
                vq[r] = *(const uint4*)(z + row * NZ + ZC_V + c); gq[r] = *(const uint4*)(gbuf + row * 512 + c); oq[r] = *(const uint4*)(O + row * 512 + c);
                cbq[r] = CB[row * 8 + (lane >> 3)];
                pq[r] = *(const f32x4*)(p + row * PLE + 4 * lane);
            }
#pragma unroll
            for (int r = 0; r < 4; ++r) {
                const size_t row = (size_t)(row0 + i4 + r);
                const float cb = cbq[r];
                float v[8], t8[8], g[8], o[8], y[8];
                unpack8(vq[r], v); unpack8(vp, t8);
#pragma unroll
                for (int j = 0; j < 8; ++j) v[j] += (t8[j] - v[j]) * muv[j];
                vp = vq[r];
                unpack8(gq[r], g); unpack8(oq[r], o);
                float sm = 0.f;
#pragma unroll
                for (int j = 0; j < 8; ++j) sm += o[j];
                sm += __shfl_xor(sm, 1); sm += __shfl_xor(sm, 2); sm += __shfl_xor(sm, 4);
                const float mean = sm * (1.0f / 64.0f); float vs = 0.f;
#pragma unroll
                for (int j = 0; j < 8; ++j) { o[j] -= mean; vs += o[j] * o[j]; }
                vs += __shfl_xor(vs, 1); vs += __shfl_xor(vs, 2); vs += __shfl_xor(vs, 4);
                const float rstd = rsqrtf(vs * (1.0f / 64.0f) + GN_EPS);
#pragma unroll
                for (int j = 0; j < 8; ++j) y[j] = (o[j] * rstd * gw8[j] + gb8[j] + cb * v[j]) * g[j];
                *(uint4*)(ycat + row * DM + 512 + c) = pack8(y);
                uint2 po; po.x = cvt_pk_bf16(pq[r].x, pq[r].y); po.y = cvt_pk_bf16(pq[r].z, pq[r].w);
                *(uint2*)(pb + row * PLE + 4 * lane) = po;
            }
        }
    }
}

__device__ __forceinline__ void phase7(const Args& A, int tid) {
    unsigned char* ws = A.ws;
    const bf16_t* SB = (const bf16_t*)(ws + WS_SB); bf16_t* ACT = (bf16_t*)(ws + WS_ACT);
    const float* cw = A.in[19]; const float* cb = A.in[20];
    const int gt = blockIdx.x * 512 + tid, NT = gridDim.x * 512;
    constexpr int CPR = DFF / 4;
    for (int it = gt; it < (MTOK / 64) * CPR; it += NT) {
        const int g = it / CPR, j = (it % CPR) * 4;
        const bool first = (g & 31) == 0;
        f32x4 act[2];
        f32x4 cvv[2][2];
#pragma unroll
        for (int ty = 0; ty < 2; ++ty) {
            const int cc = ty * DFF + j;
            const f32x4 w0 = *(const f32x4*)(cw + cc), w1 = *(const f32x4*)(cw + NUP + cc), w2 = *(const f32x4*)(cw + 2 * NUP + cc), bb = *(const f32x4*)(cb + cc);
            float t4[4];
            unpack4(*(const uint2*)(SB + ((size_t)g * 4 + 0) * NUP + cc), t4); const f32x4 u0 = (f32x4){t4[0], t4[1], t4[2], t4[3]};
            unpack4(*(const uint2*)(SB + ((size_t)g * 4 + 1) * NUP + cc), t4); const f32x4 u1 = (f32x4){t4[0], t4[1], t4[2], t4[3]};
            f32x4 p62 = (f32x4){0.f, 0.f, 0.f, 0.f}, p63 = p62;
            if (!first) { unpack4(*(const uint2*)(SB + ((size_t)(g - 1) * 4 + 2) * NUP + cc), t4); p62 = (f32x4){t4[0], t4[1], t4[2], t4[3]};
                          unpack4(*(const uint2*)(SB + ((size_t)(g - 1) * 4 + 3) * NUP + cc), t4); p63 = (f32x4){t4[0], t4[1], t4[2], t4[3]}; }
            cvv[ty][0] = w2 * u0 + w1 * p63 + w0 * p62 + bb;
            cvv[ty][1] = w2 * u1 + w1 * u0 + w0 * p63 + bb;
        }
#pragma unroll
        for (int r = 0; r < 2; ++r) {
#pragma unroll
            for (int e = 0; e < 4; ++e) { const float gc = cvv[0][r][e]; act[r][e] = gc * __builtin_amdgcn_rcpf(1.0f + __expf(-gc)) * cvv[1][r][e]; }
            uint2 o; o.x = cvt_pk_bf16(act[r][0], act[r][1]); o.y = cvt_pk_bf16(act[r][2], act[r][3]);
            *(uint2*)(ACT + ((size_t)g * 64 + r) * DFF + j) = o;
        }
    }
}

__device__ __forceinline__ void phase11(const Args& A, int lane, int wave) {
    float* out = A.out; const float* ss4 = (const float*)(A.ws + WS_SS) + 4 * MTOK; const float* fg = A.in[26];
    const bf16_t* x3 = (const bf16_t*)(A.ws + WS_E);
    const int gw = blockIdx.x * 8 + wave, NGW = gridDim.x * 8;
    f32x4 g4[4];
#pragma unroll
    for (int j = 0; j < 4; ++j) g4[j] = *((const f32x4*)fg + 4 * lane + j);
    for (int m = gw; m < MTOK; m += 2 * NGW) {
        const int m2 = m + NGW; const bool has2 = m2 < MTOK; const int mb = has2 ? m2 : m;
        const float rsa = rsqrtf(ss4[m] * (1.0f / DM) + NORM_EPS), rsb = rsqrtf(ss4[mb] * (1.0f / DM) + NORM_EPS);
        const uint4 a0 = *((const uint4*)(x3 + (size_t)m * DM) + 2 * lane), a1 = *((const uint4*)(x3 + (size_t)m * DM) + 2 * lane + 1);
        const uint4 b0_ = *((const uint4*)(x3 + (size_t)mb * DM) + 2 * lane), b1_ = *((const uint4*)(x3 + (size_t)mb * DM) + 2 * lane + 1);
        float va[16], vb[16];
        unpack8(a0, va); unpack8(a1, va + 8); unpack8(b0_, vb); unpack8(b1_, vb + 8);
        f32x4* oa = (f32x4*)(out + (size_t)m * DM) + 4 * lane; f32x4* ob = (f32x4*)(out + (size_t)mb * DM) + 4 * lane;
#pragma unroll
        for (int j = 0; j < 4; ++j) {
            oa[j] = (f32x4){va[4 * j], va[4 * j + 1], va[4 * j + 2], va[4 * j + 3]} * rsa * g4[j];
            if (has2) ob[j] = (f32x4){vb[4 * j], vb[4 * j + 1], vb[4 * j + 2], vb[4 * j + 3]} * rsb * g4[j];
        }
    }
}

#define XB_TMO      128
#define XB_XCNT(j)  (256  + 64 * (j))
#define XB_XSUB(j)  (1280 + 64 * (j))
#define XB_XGEN(j)  (2304 + 64 * (j))
#define XB_TOP      3328
#define XB_TOPGEN   3392
#define XCD_BAR_WORDS 3456
#define XB_SPIN_CAP (1u << 18)

__device__ __forceinline__ unsigned xb_ld(unsigned* p)              { return __hip_atomic_load(p, __ATOMIC_RELAXED, __HIP_MEMORY_SCOPE_AGENT); }
__device__ __forceinline__ unsigned xb_add(unsigned* p, unsigned v) { return __hip_atomic_fetch_add(p, v, __ATOMIC_RELAXED, __HIP_MEMORY_SCOPE_AGENT); }
__device__ __forceinline__ unsigned xb_xcc_id() { return (unsigned)__builtin_amdgcn_s_getreg((3 << 11) | 20) & 0xFu; }
#define XB_SPIN(cond, bar) do { unsigned _sp = 0; while (cond) { __builtin_amdgcn_s_sleep(1); \
    if ((++_sp & 255u) == 0u) { if (xb_ld(&(bar)[XB_TMO])) break; if (_sp > XB_SPIN_CAP) { atomicAdd(&(bar)[XB_TMO], 1u); break; } } } } while (0)

struct XcdBarrier {
    unsigned* bar; unsigned x;
    volatile LAS unsigned* st;
};

__device__ __forceinline__ XcdBarrier xcd_barrier_post(unsigned* bar, volatile LAS unsigned* st) {
    XcdBarrier b; b.bar = bar; b.x = xb_xcc_id(); b.st = st;
    if (threadIdx.x == 0) (void)xb_add(&bar[XB_XCNT(b.x)], 1u);
    return b;
}
__device__ __forceinline__ void xcd_barrier_complete(unsigned* bar, unsigned x, unsigned& nloc, unsigned& nx) {
    const unsigned G = gridDim.x * gridDim.y * gridDim.z;
    unsigned sum, cnt, mine, sp = 0u;
    for (;;) {
        sum = 0u; cnt = 0u; mine = 0u;
#pragma unroll
        for (unsigned j = 0; j < 16; ++j) { const unsigned c = xb_ld(&bar[XB_XCNT(j)]); sum += c; cnt += (c > 0u) ? 1u : 0u; mine = (j == x) ? c : mine; }
        if (sum == G) break;
        __builtin_amdgcn_s_sleep(1);
        if ((++sp & 255u) == 0u) { if (xb_ld(&bar[XB_TMO])) break; if (sp > XB_SPIN_CAP) { atomicAdd(&bar[XB_TMO], 1u); break; } }
    }
    nloc = mine > 0u ? mine : 1u; nx = cnt > 0u ? cnt : 1u;
}

__device__ __forceinline__ void xcd_barrier(const XcdBarrier& b) {
    asm volatile("s_waitcnt vmcnt(0)" ::: "memory");
    __syncthreads();
    if (threadIdx.x == 0) {
        unsigned* bar = b.bar;
        __builtin_amdgcn_s_waitcnt(0);
        unsigned nloc = b.st[0], nx = b.st[1];
        if (nloc == 0u) { xcd_barrier_complete(bar, b.x, nloc, nx); b.st[0] = nloc; b.st[1] = nx; }
        const unsigned old = xb_add(&bar[XB_XSUB(b.x)], 1u);
        const unsigned gen = old / nloc;
        if (old + 1u == (gen + 1u) * nloc) {
            __builtin_amdgcn_fence(__ATOMIC_RELEASE, "agent");
            asm volatile("s_waitcnt vmcnt(0)" ::: "memory");
            const unsigned og = xb_add(&bar[XB_TOP], 1u);
            const unsigned tg = og / nx;
            if (og + 1u == (tg + 1u) * nx) xb_add(&bar[XB_TOPGEN], 1u);
            else XB_SPIN(xb_ld(&bar[XB_TOPGEN]) == tg, bar);
            __builtin_amdgcn_fence(__ATOMIC_ACQUIRE, "agent");
            xb_add(&bar[XB_XGEN(b.x)], 1u);
            asm volatile("s_waitcnt vmcnt(0)" ::: "memory");
        } else {
            XB_SPIN(xb_ld(&bar[XB_XGEN(b.x)]) == gen, bar);
            __builtin_amdgcn_fence(__ATOMIC_ACQUIRE, "agent");
            asm volatile("s_waitcnt vmcnt(0)" ::: "memory");
        }
    }
    __syncthreads();
}

template <int MODE> __device__ __forceinline__ void run_gemm(LAS unsigned char* lds, const bf16_t* Aop, const bf16_t* Bt, int M, int N, int K, const Epi<MODE>& E) {
    pg8::Gemm g{Aop, Bt, M, N, K}; pg8::StaticOrder S; S.init(M, N, (int)gridDim.x, (int)blockIdx.x);
    pg8::gemm_phase<Epi<MODE>, pg8::StaticOrder, true, true>(lds, g, S, E);
}

__global__ void __launch_bounds__(512, 2) hymba_fwd(Args A) {
    extern __shared__ __attribute__((aligned(16))) unsigned char lds_raw[];
    cg::grid_group grid = cg::this_grid();
    LAS unsigned char* lds = (LAS unsigned char*)lds_raw;
    int tid, lane, wave;
#define PHASE_IDS() do { tid = threadIdx.x; asm volatile("" : "+v"(tid)); lane = tid & 63; wave = __builtin_amdgcn_readfirstlane(tid >> 6); } while (0)
    PHASE_IDS();
    unsigned char* ws = A.ws;
    float* ss = (float*)(ws + WS_SS);
    bf16_t* XB = (bf16_t*)(ws + WS_XB);

#ifndef PMASK
#define PMASK 0xFFFF
#endif
    if (PMASK & 1) phase0(A, lds, tid, lane, wave);
    grid.sync();
    ((volatile LAS unsigned*)(lds + 143360))[tid & 1] = 0u; __syncthreads();
    const XcdBarrier xbar = xcd_barrier_post((unsigned*)(ws + WS_BAR), (volatile LAS unsigned*)(lds + 143360));
#define GSYNC() xcd_barrier(xbar)

    if (PMASK & 2) {
        Epi<MODE_Z> E{}; E.row_off = 0; E.b0 = (bf16_t*)(ws + WS_Z); E.ldb = NZ; E.ssin = ss;
        run_gemm<MODE_Z>(lds, XB, (const bf16_t*)(ws + WS_WIN), MTOK, NZ, DM, E);
    }
    GSYNC();
    PHASE_IDS();
    if (PMASK & 4) phase2(A, lane, wave);
    GSYNC();
    if (PMASK & 8) {
        Epi<MODE_LORA> E{}; E.row_off = 0; E.c0 = A.in[6]; E.c1 = A.in[8]; E.f1 = (float*)(ws + WS_DEC); E.b1 = (bf16_t*)(ws + WS_A); E.b2 = (bf16_t*)(ws + WS_G);
        run_gemm<MODE_LORA>(lds, (const bf16_t*)(ws + WS_L), (const bf16_t*)(ws + WS_WLORA), MTOK, NLORA, KLORA, E);
    }
    GSYNC();
    PHASE_IDS();
    if (PMASK & 16) phase3(A, lds, tid, lane, wave);
#ifdef REP_SCAN
    GSYNC(); phase3(A, lds, tid, lane, wave);
#endif
    GSYNC();
    PHASE_IDS();
    if (PMASK & 32) phase4(A, lane, wave);
    GSYNC();
    if (PMASK & 64) {
        Epi<MODE_WOUT> E{}; E.row_off = 0; E.f0 = A.out; E.xin = A.in[0]; E.b0 = XB; E.ldb = DM; E.ssout = ss + MTOK;
        run_gemm<MODE_WOUT>(lds, (const bf16_t*)(ws + WS_YCAT), (const bf16_t*)(ws + WS_WOUT), MTOK, DM, DM, E);
    }
    if (PMASK & 1024) {
        Epi<MODE_PLE> E{}; E.row_off = 0; E.b0 = (bf16_t*)(ws + WS_E); E.ldb = DM; E.ssout = ss + 3 * MTOK;
        run_gemm<MODE_PLE>(lds, (const bf16_t*)(ws + WS_PB), (const bf16_t*)(ws + WS_WPROJ), MTOK, DM, PLE, E);
    }
    GSYNC();
    if (PMASK & 128) {
        Epi<MODE_UP> E{}; E.row_off = 0; E.b0 = (bf16_t*)(ws + WS_ACT); E.ldb = DFF; E.ssin = ss + MTOK; E.c0 = A.in[19]; E.c1 = A.in[20]; E.sb = (float*)(ws + WS_SB);
        run_gemm<MODE_UP>(lds, XB, (const bf16_t*)(ws + WS_WUP), MTOK, NUP, DM, E);
    }
    GSYNC();
    PHASE_IDS();
    if (PMASK & 256) phase7(A, tid);
    GSYNC();
    if (PMASK & 512) {
        Epi<MODE_DOWN> E{}; E.row_off = 0; E.f0 = A.out; E.b0 = XB; E.ldb = DM; E.ssout = ss + 2 * MTOK;
        run_gemm<MODE_DOWN>(lds, (const bf16_t*)(ws + WS_ACT), (const bf16_t*)(ws + WS_WDOWN), MTOK, DM, DFF, E);
    }
    GSYNC();
    if (PMASK & 2048) {
        Epi<MODE_GATE> E{}; E.row_off = 0; E.f0 = A.out; E.ssin = ss + 2 * MTOK; E.e0 = (const bf16_t*)(ws + WS_E); E.ssin2 = ss + 3 * MTOK; E.c0 = A.in[23]; E.ssout = ss + 4 * MTOK; E.b0 = XB; E.ldb = DM;
        run_gemm<MODE_GATE>(lds, XB, (const bf16_t*)(ws + WS_WGATE), MTOK, DM, DM, E);
    }
    GSYNC();
    PHASE_IDS();
    if (PMASK & 4096) phase11(A, lane, wave);
}

extern "C" void kernel_launch(void* const* d_in, const int* in_sizes, int n_in, void* d_out, int out_size, void* d_ws, size_t ws_size, hipStream_t stream) {
    static int grid_blocks = 0;
    if (grid_blocks == 0) {
        int dev = 0, cus = 0, per_cu = 0;
        hipGetDevice(&dev);
        hipDeviceGetAttribute(&cus, hipDeviceAttributeMultiprocessorCount, dev);
        hipFuncSetAttribute((const void*)hymba_fwd, hipFuncAttributeMaxDynamicSharedMemorySize, LDS_BYTES);
        hipOccupancyMaxActiveBlocksPerMultiprocessor(&per_cu, (const void*)hymba_fwd, 512, LDS_BYTES);
        if (per_cu < 1) { fprintf(stderr, "kernel_launch: occupancy query says %d blocks/CU\n", per_cu); per_cu = 1; }
        if (per_cu > 1) per_cu = 1;
        grid_blocks = cus * per_cu;
        if (ws_size < 512 * MiB) fprintf(stderr, "kernel_launch: ws_size %zu < 512 MiB\n", ws_size);
    }
    Args a{};
    for (int i = 0; i < 27; ++i) a.in[i] = (const float*)d_in[i];
    a.out = (float*)d_out; a.ws = (unsigned char*)d_ws;
    void* args[] = {&a};
    hipError_t e = hipLaunchCooperativeKernel((const void*)hymba_fwd, dim3(grid_blocks), dim3(512), args, LDS_BYTES, stream);
    if (e != hipSuccess) fprintf(stderr, "cooperative launch failed: %s (grid %d)\n", hipGetErrorString(e), grid_blocks);
}
```

```cpp
#include <hip/hip_runtime.h>
#include <hip/hip_cooperative_groups.h>
#include <cstdio>
#include <cstdint>
namespace cg = cooperative_groups;
namespace pg8 {
#define PG8_LAS __attribute__((address_space(3)))
typedef unsigned short bf16_t;
typedef short bf16x8 __attribute__((ext_vector_type(8)));
typedef float f32x4 __attribute__((ext_vector_type(4)));
typedef unsigned u32x4 __attribute__((ext_vector_type(4)));
constexpr int BM = 256, BK = 64, HALF = 128, HTB = HALF * BK * 2  , STAGE_BYTES = 8 * HTB, NXCD = 8, WGM = 8;

__host__ __device__ __forceinline__ int lds_byte(int r, int c) { const int st = (r >> 4) * 2 + (c >> 5), rr = r & 15, cc = c & 31, ob = rr * 64 + cc * 2; return st * 1024 + (ob ^ (((ob >> 9) & 1) << 5)); }
__host__ __device__ __forceinline__ void stage_rc(int b, int& R, int& C) { const int st = b / 1024, sb = b % 1024, swz = sb ^ (((sb >> 9) & 1) << 5); R = (st >> 1) * 16 + swz / 64; C = (st & 1) * 32 + (swz % 64) / 2; }
__host__ __device__ __forceinline__ int perm32(int rho) { const int n = rho >> 4, i = rho & 15; return 8 * (i >> 2) + 4 * n + (i & 3); }

struct Unit { int pm, pn; };
struct Gemm { const bf16_t* A; const bf16_t* Bt; int M, N, K; };

struct StaticOrder {
    int nM, nN, nwg, G, c;
    __host__ __device__ void init(int M, int N, int G_, int c_) { nM = M / BM; nN = N / BM; nwg = nM * nN; G = G_; c = c_; }
    __host__ __device__ bool next(int i, Unit& u) const {
        const long L = (long)i * G + c; if (L >= nwg) return false;
        int wgid = (int)L; { const int q = nwg / NXCD, r = nwg % NXCD, xcd = wgid % NXCD, off = wgid / NXCD; wgid = (xcd < r ? xcd * (q + 1) : r * (q + 1) + (xcd - r) * q) + off; }
        const int nig = WGM * nN, gid = wgid / nig, fm = gid * WGM, gsz = (nM - fm) < WGM ? (nM - fm) : WGM;
        u.pm = fm + ((wgid % nig) % gsz); u.pn = (wgid % nig) / gsz; return true;
    }
    __device__ __forceinline__ void a_ready(const Unit&) const {}
    __device__ __forceinline__ void done(const Unit&) const {}
};
__device__ __forceinline__ unsigned cvt_pk_bf16(float lo, float hi) { unsigned r; asm volatile("s_nop 0\n\tv_cvt_pk_bf16_f32 %0, %1, %2" : "=v"(r) : "v"(lo), "v"(hi)); return r; }
template <class Epi, class Sched, bool ALIGN_EPI = false, bool SP2 = false>
__device__ __forceinline__ void gemm_phase(PG8_LAS unsigned char* lds, const Gemm g, const Sched& S, const Epi& E) {
    int tid_ = threadIdx.x; asm volatile("" : "+v"(tid_));
    const int tid = tid_, wid = __builtin_amdgcn_readfirstlane(tid >> 6), lane = tid & 63, wr = wid >> 2, wc = wid & 3, fr = lane & 15, fq = lane >> 4;
    const int K = g.K, nt = K / BK;
    unsigned voffA[2], voffB[2];
#pragma unroll
    for (int i = 0; i < 2; ++i) { int R, C; stage_rc(tid * 16 + i * 8192, R, C); const int Rb = Epi::PERM ? ((R & ~31) + perm32(R & 31)) : R;
        voffA[i] = (unsigned)(R * K + C) * 2u; voffB[i] = (unsigned)(Rb * K + C) * 2u; }
    const size_t kstep = (size_t)(BK * 2);
    const size_t hstep = (size_t)HALF * K * 2;
    const size_t tstep = 2 * hstep;
    const unsigned ldsw = (unsigned)wid * 1024u;
    const int aoff = lds_byte(wr * 64 + fr, fq * 8), boff = lds_byte(wc * 32 + fr, fq * 8);
#define PG8_SA(b, h) (((b) * 2 + (h)) * HTB)
#define PG8_SB(b, h) ((4 + (b) * 2 + (h)) * HTB)
#define PG8_STAGE(bufoff, gbase, voff) do { _Pragma("unroll") for (int _i = 0; _i < 2; ++_i) \
        __builtin_amdgcn_global_load_lds((const unsigned*)((const char*)(gbase) + (voff)[_i]), (PG8_LAS unsigned*)(lds + (bufoff) + ldsw + _i * 8192), 16, 0, 0); } while (0)
#define PG8_LDA(dst, b, h) do { _Pragma("unroll") for (int m = 0; m < 4; ++m) _Pragma("unroll") for (int k = 0; k < 2; ++k) dst[m][k] = *(const PG8_LAS bf16x8*)(lds + PG8_SA(b, h) + aoff + m * 2048 + k * 1024); } while (0)
#define PG8_LDB(dst, b, h) do { _Pragma("unroll") for (int n = 0; n < 2; ++n) _Pragma("unroll") for (int k = 0; k < 2; ++k) dst[n][k] = *(const PG8_LAS bf16x8*)(lds + PG8_SB(b, h) + boff + n * 2048 + k * 1024); } while (0)
#define PG8_MMA(ai, bj, At, Bt) do { __builtin_amdgcn_s_setprio(1); _Pragma("unroll") for (int m = 0; m < 4; ++m) _Pragma("unroll") for (int n = 0; n < 2; ++n) _Pragma("unroll") for (int k = 0; k < 2; ++k) \
        acc[ai][bj][m][n] = __builtin_amdgcn_mfma_f32_16x16x32_bf16(Bt[n][k], At[m][k], acc[ai][bj][m][n], 0, 0, 0); __builtin_amdgcn_s_setprio(0); } while (0)
#define PG8_WAIT_V(n) asm volatile("s_waitcnt vmcnt(" #n ")" ::: "memory")
#define PG8_WAIT_L(n) asm volatile("s_waitcnt lgkmcnt(" #n ")" ::: "memory")
#define PG8_BAR __builtin_amdgcn_s_barrier()
#define PG8_SCHED __builtin_amdgcn_sched_barrier(0)
    Unit cur, nxt; int ui = 0;
    if (!S.next(0, cur)) return;
    f32x4 acc[2][2][4][2];
#pragma unroll
    for (int a = 0; a < 2; ++a)
#pragma unroll
        for (int b = 0; b < 2; ++b)
#pragma unroll
            for (int m = 0; m < 4; ++m)
#pragma unroll
                for (int n = 0; n < 2; ++n) acc[a][b][m][n] = (f32x4){0.f, 0.f, 0.f, 0.f};
    bf16x8 At[4][2], B0[2][2], B1[2][2];
    const char* cA = (const char*)g.A + (size_t)cur.pm * tstep; const char* cB = (const char*)g.Bt + (size_t)cur.pn * tstep;
    S.a_ready(cur);
    if constexpr (SP2) {
        PG8_STAGE(PG8_SB(0, 0), cB, voffB); PG8_STAGE(PG8_SB(0, 1), cB + hstep, voffB); PG8_STAGE(PG8_SA(0, 0), cA, voffA); PG8_STAGE(PG8_SA(0, 1), cA + hstep, voffA);
        if (wr == 1) PG8_BAR;
        PG8_WAIT_V(2); PG8_BAR;
        PG8_STAGE(PG8_SB(1, 0), cB + kstep, voffB); PG8_STAGE(PG8_SA(1, 0), cA + kstep, voffA); PG8_STAGE(PG8_SB(1, 1), cB + hstep + kstep, voffB);
        PG8_WAIT_V(6); PG8_BAR;
    } else {
        PG8_STAGE(PG8_SB(0, 0), cB, voffB); PG8_STAGE(PG8_SA(0, 0), cA, voffA); PG8_STAGE(PG8_SB(0, 1), cB + hstep, voffB); PG8_STAGE(PG8_SA(0, 1), cA + hstep, voffA);
        if (wr == 1) PG8_BAR;
        PG8_WAIT_V(4); PG8_BAR;
        PG8_STAGE(PG8_SB(1, 0), cB + kstep, voffB); PG8_STAGE(PG8_SA(1, 0), cA + kstep, voffA); PG8_STAGE(PG8_SB(1, 1), cB + hstep + kstep, voffB);
        PG8_WAIT_V(6); PG8_BAR;
    }
    for (;;) {
        const bool has_next = S.next(ui + 1, nxt);
        const char* nA = has_next ? (const char*)g.A + (size_t)nxt.pm * tstep : cA; const char* nB = has_next ? (const char*)g.Bt + (size_t)nxt.pn * tstep : cB;
        for (int t = 0; t < nt; t += 2) {
            const bool last = (t == nt - 2);
            const char* a1 = cA + (size_t)(t + 1) * kstep;
            const char* a2 = last ? nA : cA + (size_t)(t + 2) * kstep; const char* b2 = last ? nB : cB + (size_t)(t + 2) * kstep;
            const char* a3 = a2 + kstep; const char* b3 = b2 + kstep;
            if (last && has_next) S.a_ready(nxt);
            if constexpr (SP2) {
            PG8_LDB(B0, 0, 0); PG8_LDB(B1, 0, 1); PG8_SCHED; PG8_LDA(At, 0, 0); PG8_STAGE(PG8_SA(1, 1), a1 + hstep, voffA);
            PG8_WAIT_V(8); PG8_WAIT_L(0); PG8_BAR; PG8_MMA(0, 0, At, B0); PG8_MMA(0, 1, At, B1); PG8_BAR; PG8_SCHED;
            PG8_LDA(At, 0, 1); PG8_STAGE(PG8_SB(0, 0), b2, voffB); PG8_STAGE(PG8_SB(0, 1), b2 + hstep, voffB); PG8_STAGE(PG8_SA(0, 0), a2, voffA);
            PG8_WAIT_V(8); PG8_WAIT_L(0); PG8_BAR; PG8_MMA(1, 0, At, B0); PG8_MMA(1, 1, At, B1); PG8_BAR; PG8_SCHED;
            PG8_LDB(B0, 1, 0); PG8_LDB(B1, 1, 1); PG8_SCHED; PG8_LDA(At, 1, 0); PG8_STAGE(PG8_SA(0, 1), a2 + hstep, voffA);
            PG8_WAIT_V(8); PG8_WAIT_L(0); PG8_BAR; PG8_MMA(0, 0, At, B0); PG8_MMA(0, 1, At, B1); PG8_BAR; PG8_SCHED;
            PG8_LDA(At, 1, 1); PG8_STAGE(PG8_SB(1, 0), b3, voffB); PG8_STAGE(PG8_SB(1, 1), b3 + hstep, voffB); PG8_STAGE(PG8_SA(1, 0), a3, voffA);
            PG8_WAIT_V(8); PG8_WAIT_L(0); PG8_BAR; PG8_MMA(1, 0, At, B0); PG8_MMA(1, 1, At, B1); PG8_BAR; PG8_SCHED;
            } else {
            PG8_LDB(B0, 0, 0); PG8_SCHED; PG8_LDA(At, 0, 0); PG8_STAGE(PG8_SA(1, 1), a1 + hstep, voffA);
            PG8_WAIT_L(8); PG8_BAR; PG8_WAIT_L(0); PG8_MMA(0, 0, At, B0); PG8_BAR; PG8_SCHED;
            PG8_LDB(B1, 0, 1); PG8_STAGE(PG8_SB(0, 0), b2, voffB);
            PG8_BAR; PG8_WAIT_L(0); PG8_MMA(0, 1, At, B1); PG8_BAR;
            PG8_LDA(At, 0, 1); PG8_STAGE(PG8_SA(0, 0), a2, voffA);
            PG8_BAR; PG8_WAIT_L(0); PG8_MMA(1, 0, At, B0); PG8_BAR; PG8_SCHED;
            PG8_STAGE(PG8_SB(0, 1), b2 + hstep, voffB);
            PG8_WAIT_V(6); PG8_BAR; PG8_MMA(1, 1, At, B1); PG8_BAR;
            PG8_LDB(B0, 1, 0); PG8_SCHED; PG8_LDA(At, 1, 0); PG8_STAGE(PG8_SA(0, 1), a2 + hstep, voffA);
            PG8_WAIT_L(8); PG8_BAR; PG8_WAIT_L(0); PG8_MMA(0, 0, At, B0); PG8_BAR; PG8_SCHED;
            PG8_LDB(B1, 1, 1); PG8_STAGE(PG8_SB(1, 0), b3, voffB);
            PG8_BAR; PG8_WAIT_L(0); PG8_MMA(0, 1, At, B1); PG8_BAR;
            PG8_LDA(At, 1, 1); PG8_STAGE(PG8_SA(1, 0), a3, voffA);
            PG8_BAR; PG8_WAIT_L(0); PG8_MMA(1, 0, At, B0); PG8_BAR; PG8_SCHED;
            PG8_STAGE(PG8_SB(1, 1), b3 + hstep, voffB);
            PG8_WAIT_V(6); PG8_BAR; PG8_MMA(1, 1, At, B1); PG8_BAR;
            }
        }
        if constexpr (ALIGN_EPI) { if (wr == 0) PG8_BAR; }
        if constexpr (!Epi::AFTER_DRAIN) { E(acc, cur, wr, wc, fr, fq); S.done(cur); }
        if (!has_next) break;
#pragma unroll
        for (int a = 0; a < 2; ++a)
#pragma unroll
            for (int b = 0; b < 2; ++b)
#pragma unroll
                for (int m = 0; m < 4; ++m)
#pragma unroll
                    for (int n = 0; n < 2; ++n) acc[a][b][m][n] = (f32x4){0.f, 0.f, 0.f, 0.f};
        cur = nxt; cA = nA; cB = nB; ++ui;
        if constexpr (ALIGN_EPI) { if (wr == 1) PG8_BAR; }
    }
    PG8_WAIT_V(0);
    if constexpr (!ALIGN_EPI) { if (wr == 0) PG8_BAR; }
    PG8_BAR;
    if constexpr (Epi::AFTER_DRAIN) { E.fused(acc, cur, wr, wc, fr, fq, lds, wid, lane); S.done(cur); }
#undef PG8_SA
#undef PG8_SB
#undef PG8_STAGE
#undef PG8_LDA
#undef PG8_LDB
#undef PG8_MMA
#undef PG8_WAIT_V
#undef PG8_WAIT_L
#undef PG8_BAR
#undef PG8_SCHED
}
}

#define LAS __attribute__((address_space(3)))
typedef unsigned short bf16_t;
typedef float f32x4 __attribute__((ext_vector_type(4)));
using pg8::cvt_pk_bf16;

constexpr int NB = 16, SEQ = 2048, DM = 1024, MTOK = NB * SEQ;
constexpr int NZ = 3328, CWID = 512, RWID = 512, NHEAD = 8, DFF = 2816, NUP = 5632, PLE = 256, NLORA = 1536, KLORA = 256;
constexpr int ZC_R = 1536, ZC_K = 2048, ZC_V = 2560, ZC_L = 3072;
constexpr int MH = MTOK / 2;
constexpr float NORM_EPS = 1e-6f, GN_EPS = 64e-5f;
constexpr int LDS_BYTES = 147456;

constexpr size_t MiB = 1u << 20;
constexpr size_t WS_BAR = 768 * 1024;
constexpr size_t WS_SS = 0;
constexpr size_t WS_WIN = 1 * MiB, WS_WLORA = 8 * MiB, WS_WOUT = 9 * MiB, WS_WUP = 11 * MiB, WS_WDOWN = 22 * MiB, WS_WPROJ = 28 * MiB, WS_WGATE = 29 * MiB;
constexpr size_t WS_CB = 31 * MiB;
constexpr size_t WS_XB = 32 * MiB;
constexpr size_t WS_Z = 96 * MiB;
constexpr size_t WS_L = 304 * MiB;
constexpr size_t WS_DEC = 320 * MiB;
constexpr size_t WS_A = 384 * MiB;
constexpr size_t WS_G = 416 * MiB;
constexpr size_t WS_YCAT = 448 * MiB;
constexpr size_t WS_O = 352 * MiB;
constexpr size_t WS_ACT = 96 * MiB;
constexpr size_t WS_SB = 272 * MiB;
constexpr size_t WS_PB = 304 * MiB;
constexpr size_t WS_E = 384 * MiB;

struct Args { const float* in[27]; float* out; unsigned char* ws; };

__device__ __forceinline__ void unpack8(const uint4 u, float* f) {
    f[0] = __uint_as_float(u.x << 16); f[1] = __uint_as_float(u.x & 0xffff0000u);
    f[2] = __uint_as_float(u.y << 16); f[3] = __uint_as_float(u.y & 0xffff0000u);
    f[4] = __uint_as_float(u.z << 16); f[5] = __uint_as_float(u.z & 0xffff0000u);
    f[6] = __uint_as_float(u.w << 16); f[7] = __uint_as_float(u.w & 0xffff0000u);
}
__device__ __forceinline__ void unpack4(const uint2 u, float* f) {
    f[0] = __uint_as_float(u.x << 16); f[1] = __uint_as_float(u.x & 0xffff0000u);
    f[2] = __uint_as_float(u.y << 16); f[3] = __uint_as_float(u.y & 0xffff0000u);
}
__device__ __forceinline__ uint4 pack8(const float* f) {
    uint4 r; r.x = cvt_pk_bf16(f[0], f[1]); r.y = cvt_pk_bf16(f[2], f[3]); r.z = cvt_pk_bf16(f[4], f[5]); r.w = cvt_pk_bf16(f[6], f[7]); return r;
}
__device__ __forceinline__ float sigmoidf_(float x) { return __builtin_amdgcn_rcpf(1.0f + __expf(-x)); }
__device__ __forceinline__ float wave_sum(float v) {
#pragma unroll
    for (int o = 1; o < 64; o <<= 1) v += __shfl_xor(v, o);
    return v;
}
template <int CTRL> __device__ __forceinline__ float dppf(float x) { return __int_as_float(__builtin_amdgcn_update_dpp(0, __float_as_int(x), CTRL, 0xF, 0xF, true)); }
__device__ __forceinline__ float reduce16(float x) { x += dppf<0xB1>(x); x += dppf<0x4E>(x); x += dppf<0x124>(x); x += dppf<0x128>(x); return x; }

enum { MODE_Z = 0, MODE_LORA = 1, MODE_WOUT = 2, MODE_UP = 3, MODE_DOWN = 4, MODE_PLE = 5, MODE_GATE = 6 };
template <int MODE> struct Epi {
    static constexpr bool PERM = true, AFTER_DRAIN = false;
    int row_off;
    float* f0; const float* xin;
    bf16_t* b0; int ldb;
    const float* ssin; float* ssout;
    const float* c0; const float* c1;
    float* f1; bf16_t* b1; bf16_t* b2;
    const bf16_t* e0; const float* ssin2;
    float* sb;

    __device__ __forceinline__ void up_fused(const f32x4 (&acc)[2][2][4][2], const pg8::Unit& u, int wr, int wc, int fr, int fq) const {
        const int jcol = u.pn * 128 + wc * 32 + 8 * fq;
        float rsr[2][4];
#pragma unroll
        for (int ai = 0; ai < 2; ++ai)
#pragma unroll
            for (int m = 0; m < 4; ++m) rsr[ai][m] = rsqrtf(ssin[u.pm * 256 + ai * 128 + wr * 64 + m * 16 + fr] * (1.0f / DM) + NORM_EPS);
        if (fr < 2 || fr >= 14) {
            const int mm = fr < 2 ? 0 : 3, slot = fr < 2 ? fr : fr - 12;
#pragma unroll
            for (int ai = 0; ai < 2; ++ai) {
                const int g = u.pm * 4 + ai * 2 + wr;
                const float sc = fr < 2 ? rsr[ai][0] : rsr[ai][3];
#pragma unroll
                for (int bj = 0; bj < 2; ++bj) {
                    bf16_t* dst = (bf16_t*)sb + ((size_t)g * 4 + slot) * NUP + bj * DFF + jcol;
                    const f32x4 a0 = (fr < 2 ? acc[ai][bj][0][0] : acc[ai][bj][3][0]) * sc, a1 = (fr < 2 ? acc[ai][bj][0][1] : acc[ai][bj][3][1]) * sc;
                    uint4 o; o.x = cvt_pk_bf16(a0[0], a0[1]); o.y = cvt_pk_bf16(a0[2], a0[3]); o.z = cvt_pk_bf16(a1[0], a1[1]); o.w = cvt_pk_bf16(a1[2], a1[3]);
                    *(uint4*)dst = o;
                }
            }
            (void)mm;
        }
        unsigned outp[2][4][4];
        const bool ge1 = fr >= 1, ge2 = fr >= 2;
#pragma unroll
        for (int ip = 0; ip < 4; ++ip) {
            float actv[2][2][4];
#pragma unroll
            for (int ic = 0; ic < 2; ++ic) {
                const int i = 2 * ip + ic, n = i >> 2, e = i & 3;
                float cv[2][2][4];
#pragma unroll
                for (int bj = 0; bj < 2; ++bj) {
                    const int cc = bj * DFF + jcol + i;
                    const float w0 = c0[cc], w1 = c0[NUP + cc], w2 = c0[2 * NUP + cc], bb = c1[cc];
#pragma unroll
                    for (int ai = 0; ai < 2; ++ai) {
                        float r1p = 0.f, r2p = 0.f;
#pragma unroll
                        for (int m = 0; m < 4; ++m) {
                            const float X = acc[ai][bj][m][n][e] * rsr[ai][m];
                            const float r1 = dppf<0x121>(X), r2 = dppf<0x122>(X);
                            const float p1 = ge1 ? r1 : r1p, p2 = ge2 ? r2 : r2p;
                            cv[bj][ai][m] = w2 * X + (w1 * p1 + (w0 * p2 + bb));
                            r1p = r1; r2p = r2;
                        }
                    }
                }
#pragma unroll
                for (int ai = 0; ai < 2; ++ai)
#pragma unroll
                    for (int m = 0; m < 4; ++m) { const float gc = cv[0][ai][m]; actv[ic][ai][m] = gc * __builtin_amdgcn_rcpf(1.0f + __expf(-gc)) * cv[1][ai][m]; }
            }
#pragma unroll
            for (int ai = 0; ai < 2; ++ai)
#pragma unroll
                for (int m = 0; m < 4; ++m) outp[ai][m][ip] = cvt_pk_bf16(actv[0][ai][m], actv[1][ai][m]);
        }
#pragma unroll
        for (int ai = 0; ai < 2; ++ai)
#pragma unroll
            for (int m = 0; m < 4; ++m) {
                if (m == 0 && fr < 2) continue;
                const int row = u.pm * 256 + ai * 128 + wr * 64 + m * 16 + fr;
                uint4 o; o.x = outp[ai][m][0]; o.y = outp[ai][m][1]; o.z = outp[ai][m][2]; o.w = outp[ai][m][3];
                *(uint4*)(b0 + (size_t)row * DFF + jcol) = o;
            }
    }
    __device__ __forceinline__ void operator()(const f32x4 (&acc)[2][2][4][2], const pg8::Unit& u, int wr, int wc, int fr, int fq) const {
        if (MODE == MODE_UP) { up_fused(acc, u, wr, wc, fr, fq); return; }
        const int rowb = row_off + u.pm * 256 + wr * 64 + fr;
        const int colb = u.pn * 256 + wc * 32 + 8 * fq;
        float rs[2][4], rs2[2][4];
        if (MODE == MODE_Z || MODE == MODE_GATE) {
#pragma unroll
            for (int ai = 0; ai < 2; ++ai)
#pragma unroll
                for (int m = 0; m < 4; ++m) { rs[ai][m] = ssin[rowb + ai * 128 + m * 16]; if (MODE == MODE_GATE) rs2[ai][m] = ssin2[rowb + ai * 128 + m * 16]; }
#pragma unroll
            for (int ai = 0; ai < 2; ++ai)
#pragma unroll
                for (int m = 0; m < 4; ++m) { rs[ai][m] = rsqrtf(rs[ai][m] * (1.0f / DM) + NORM_EPS); if (MODE == MODE_GATE) rs2[ai][m] = rsqrtf(rs2[ai][m] * (1.0f / DM) + NORM_EPS); }
        }
        if (MODE == MODE_Z) {
#pragma unroll
            for (int ai = 0; ai < 2; ++ai)
#pragma unroll
                for (int m = 0; m < 4; ++m)
#pragma unroll
                    for (int bj = 0; bj < 2; ++bj) {
                        const f32x4 a = acc[ai][bj][m][0] * rs[ai][m], b = acc[ai][bj][m][1] * rs[ai][m];
                        uint4 o; o.x = cvt_pk_bf16(a[0], a[1]); o.y = cvt_pk_bf16(a[2], a[3]); o.z = cvt_pk_bf16(b[0], b[1]); o.w = cvt_pk_bf16(b[2], b[3]);
                        *(uint4*)(b0 + (size_t)(rowb + ai * 128 + m * 16) * ldb + colb + bj * 128) = o;
                    }
        } else if (MODE == MODE_LORA) {
#pragma unroll
            for (int ai = 0; ai < 2; ++ai)
#pragma unroll
                for (int m = 0; m < 4; ++m) {
                    const int row = rowb + ai * 128 + m * 16;
#pragma unroll
                    for (int bj = 0; bj < 2; ++bj) {
                        const int col = colb + bj * 128;
                        float v[8];
#pragma unroll
                        for (int i = 0; i < 4; ++i) { v[i] = acc[ai][bj][m][0][i]; v[4 + i] = acc[ai][bj][m][1][i]; }
                        if (u.pn < 2) *(uint4*)((bf16_t*)f1 + (size_t)row * 512 + col) = pack8(v);
                        else if (u.pn < 4) *(uint4*)(b1 + (size_t)row * 512 + col - 512) = pack8(v);
                        else *(uint4*)(b2 + (size_t)row * 512 + col - 1024) = pack8(v);
                    }
                }
        } else if (MODE == MODE_PLE) {
#pragma unroll
            for (int ai = 0; ai < 2; ++ai)
#pragma unroll
                for (int m = 0; m < 4; ++m) {
                    float ssacc = 0.f;
#pragma unroll
                    for (int bj = 0; bj < 2; ++bj) {
                        float v[8];
#pragma unroll
                        for (int i = 0; i < 4; ++i) { v[i] = acc[ai][bj][m][0][i]; v[4 + i] = acc[ai][bj][m][1][i]; }
#pragma unroll
                        for (int i = 0; i < 8; ++i) ssacc += v[i] * v[i];
                        *(uint4*)(b0 + (size_t)(rowb + ai * 128 + m * 16) * ldb + colb + bj * 128) = pack8(v);
                    }
                    ssacc += __shfl_xor(ssacc, 16); ssacc += __shfl_xor(ssacc, 32);
                    if (fq == 0) atomicAdd(ssout + rowb + ai * 128 + m * 16, ssacc);
                }
        } else if (MODE == MODE_WOUT || MODE == MODE_DOWN) {
#pragma unroll
            for (int ai = 0; ai < 2; ++ai) {
                f32x4 res[4][2][2];
                {
                    uint4 rb[4][2];
#pragma unroll
                    for (int m = 0; m < 4; ++m)
#pragma unroll
                        for (int bj = 0; bj < 2; ++bj) rb[m][bj] = *(const uint4*)(b0 + (size_t)(rowb + ai * 128 + m * 16) * ldb + colb + bj * 128);
#pragma unroll
                    for (int m = 0; m < 4; ++m)
#pragma unroll
                        for (int bj = 0; bj < 2; ++bj) { float t8[8]; unpack8(rb[m][bj], t8); res[m][bj][0] = (f32x4){t8[0], t8[1], t8[2], t8[3]}; res[m][bj][1] = (f32x4){t8[4], t8[5], t8[6], t8[7]}; }
                }
                float ssr[4];
#pragma unroll
                for (int m = 0; m < 4; ++m) {
                    float ssacc = 0.f;
#pragma unroll
                    for (int bj = 0; bj < 2; ++bj) {
                        const f32x4 a = acc[ai][bj][m][0] + res[m][bj][0], b = acc[ai][bj][m][1] + res[m][bj][1];
                        ssacc += (a[0] * a[0] + a[1] * a[1]) + (a[2] * a[2] + a[3] * a[3]) + (b[0] * b[0] + b[1] * b[1]) + (b[2] * b[2] + b[3] * b[3]);
                        uint4 o; o.x = cvt_pk_bf16(a[0], a[1]); o.y = cvt_pk_bf16(a[2], a[3]); o.z = cvt_pk_bf16(b[0], b[1]); o.w = cvt_pk_bf16(b[2], b[3]);
                        *(uint4*)(b0 + (size_t)(rowb + ai * 128 + m * 16) * ldb + colb + bj * 128) = o;
                    }
                    ssacc += __shfl_xor(ssacc, 16); ssacc += __shfl_xor(ssacc, 32); ssr[m] = ssacc;
                }
                if (fq == 0) {
#pragma unroll
                    for (int m = 0; m < 4; ++m) atomicAdd(ssout + rowb + ai * 128 + m * 16, ssr[m]);
                }
            }
        } else if (MODE == MODE_GATE) {
            float ssr[2][4];
#pragma unroll
            for (int ai = 0; ai < 2; ++ai)
#pragma unroll
                for (int m = 0; m < 4; ++m) ssr[ai][m] = 0.f;
#pragma unroll
            for (int bj = 0; bj < 2; ++bj) {
                const f32x4 ca = *(const f32x4*)(c0 + colb + bj * 128), cb = *(const f32x4*)(c0 + colb + bj * 128 + 4);
#pragma unroll
                for (int ai = 0; ai < 2; ++ai)
#pragma unroll
                    for (int mp = 0; mp < 2; ++mp) {
                        f32x4 res[2][2]; uint4 eb[2], xr[2];
#pragma unroll
                        for (int mm = 0; mm < 2; ++mm) {
                            const size_t off = (size_t)(rowb + ai * 128 + (2 * mp + mm) * 16) * DM + colb + bj * 128;
                            xr[mm] = *(const uint4*)(b0 + off); eb[mm] = *(const uint4*)(e0 + off);
                        }
#pragma unroll
                        for (int mm = 0; mm < 2; ++mm) { float t8[8]; unpack8(xr[mm], t8); res[mm][0] = (f32x4){t8[0], t8[1], t8[2], t8[3]}; res[mm][1] = (f32x4){t8[4], t8[5], t8[6], t8[7]}; }
#pragma unroll
                        for (int mm = 0; mm < 2; ++mm) {
                            const int m = 2 * mp + mm;
                            float e8[8]; unpack8(eb[mm], e8);
                            f32x4 a, b;
#pragma unroll
                            for (int i = 0; i < 4; ++i) {
                                a[i] = res[mm][0][i] + sigmoidf_(acc[ai][bj][m][0][i] * rs[ai][m]) * (e8[i] * rs2[ai][m] * ca[i]);
                                b[i] = res[mm][1][i] + sigmoidf_(acc[ai][bj][m][1][i] * rs[ai][m]) * (e8[4 + i] * rs2[ai][m] * cb[i]);
                            }
                            ssr[ai][m] += (a[0] * a[0] + a[1] * a[1]) + (a[2] * a[2] + a[3] * a[3]) + (b[0] * b[0] + b[1] * b[1]) + (b[2] * b[2] + b[3] * b[3]);
                            const size_t off = (size_t)(rowb + ai * 128 + m * 16) * DM + colb + bj * 128;
                            uint4 o; o.x = cvt_pk_bf16(a[0], a[1]); o.y = cvt_pk_bf16(a[2], a[3]); o.z = cvt_pk_bf16(b[0], b[1]); o.w = cvt_pk_bf16(b[2], b[3]);
                            *(uint4*)(const_cast<bf16_t*>(e0) + off) = o;
                        }
                    }
            }
#pragma unroll
            for (int ai = 0; ai < 2; ++ai)
#pragma unroll
                for (int m = 0; m < 4; ++m) {
                    float t = ssr[ai][m]; t += __shfl_xor(t, 16); t += __shfl_xor(t, 32);
                    if (fq == 0) atomicAdd(ssout + rowb + ai * 128 + m * 16, t);
                }
        }
    }
};

template <bool UPMAP> __device__ __forceinline__ void p0_transpose_item(const float* W, int K, int N, bf16_t* WT, const float* gain, LAS float* scr, int item, int lane, int ldw = 0) {
    if (ldw == 0) ldw = K;
    const int nblk = N / 32, kb = item / nblk, nb = item % nblk, k0 = 64 * kb, n0 = 32 * nb;
    const int p = lane >> 5, l31 = lane & 31, c = lane & 7;
    float r[32];
#pragma unroll
    for (int i = 0; i < 32; ++i) r[i] = W[(size_t)(k0 + 2 * i + p) * N + n0 + l31];
    f32x4 ga = (f32x4){1.f, 1.f, 1.f, 1.f}, gb = ga;
    if (gain) { ga = *(const f32x4*)(gain + k0 + 8 * c); gb = *(const f32x4*)(gain + k0 + 8 * c + 4); }
#pragma unroll
    for (int i = 0; i < 32; ++i) scr[(2 * i + p) * 33 + l31] = r[i];
    asm volatile("s_waitcnt lgkmcnt(0)" ::: "memory");
#pragma unroll
    for (int j = 0; j < 4; ++j) { const int n = (lane >> 3) + 8 * j; const LAS float* s = scr + (8 * c) * 33 + n;
        uint4 o; o.x = cvt_pk_bf16(s[0 * 33] * ga[0], s[1 * 33] * ga[1]); o.y = cvt_pk_bf16(s[2 * 33] * ga[2], s[3 * 33] * ga[3]); o.z = cvt_pk_bf16(s[4 * 33] * gb[0], s[5 * 33] * gb[1]); o.w = cvt_pk_bf16(s[6 * 33] * gb[2], s[7 * 33] * gb[3]);
        int nd = n0 + n; if (UPMAP) { const int hv = nd >= DFF ? 1 : 0, mloc = nd - hv * DFF; nd = (mloc >> 7) * 256 + hv * 128 + (mloc & 127); }
        *(uint4*)(WT + (size_t)nd * ldw + k0 + 8 * c) = o; }
    asm volatile("s_waitcnt lgkmcnt(0)" ::: "memory");
}

template <bool UPMAP> __device__ __forceinline__ void transpose_half_item(const float* W, int K, int N, bf16_t* WT, const float* gain, LAS float* scr, int item, int lane) {
    const int nblk = N / 32, kb = item / nblk, nb = item % nblk, k0 = 32 * kb, n0 = 32 * nb;
    const int p = lane >> 5, l31 = lane & 31, c = lane & 3;
    float r[16];
#pragma unroll
    for (int i = 0; i < 16; ++i) r[i] = W[(size_t)(k0 + 2 * i + p) * N + n0 + l31];
    f32x4 ga = (f32x4){1.f, 1.f, 1.f, 1.f}, gb = ga;
    if (gain) { ga = *(const f32x4*)(gain + k0 + 8 * c); gb = *(const f32x4*)(gain + k0 + 8 * c + 4); }
#pragma unroll
    for (int i = 0; i < 16; ++i) scr[(2 * i + p) * 33 + l31] = r[i];
    asm volatile("s_waitcnt lgkmcnt(0)" ::: "memory");
#pragma unroll
    for (int j = 0; j < 2; ++j) { const int n = (lane >> 2) + 16 * j; const LAS float* s = scr + (8 * c) * 33 + n;
        uint4 o; o.x = cvt_pk_bf16(s[0 * 33] * ga[0], s[1 * 33] * ga[1]); o.y = cvt_pk_bf16(s[2 * 33] * ga[2], s[3 * 33] * ga[3]); o.z = cvt_pk_bf16(s[4 * 33] * gb[0], s[5 * 33] * gb[1]); o.w = cvt_pk_bf16(s[6 * 33] * gb[2], s[7 * 33] * gb[3]);
        int nd = n0 + n; if (UPMAP) { const int hv = nd >= DFF ? 1 : 0, mloc = nd - hv * DFF; nd = (mloc >> 7) * 256 + hv * 128 + (mloc & 127); }
        *(uint4*)(WT + (size_t)nd * K + k0 + 8 * c) = o; }
    asm volatile("s_waitcnt lgkmcnt(0)" ::: "memory");
}
constexpr int I_IN = (DM / 64) * (NZ / 32), I_OUT = (DM / 64) * (DM / 32), I_UP = (DM / 64) * (NUP / 32), I_DOWN = (DFF / 64) * (DM / 32), I_PROJ = (PLE / 64) * (DM / 32), I_GATE = I_OUT;
constexpr int I_LW = 16, I_LA = 16, I_LG = 32;
constexpr int N_EARLY = I_IN + I_LW + I_LA + I_LG, N_LATE = 2 * (I_OUT + I_UP + I_DOWN + I_PROJ + I_GATE);
constexpr size_t WS_PTAB = 832 * 1024;
__device__ __forceinline__ void late_weight_item(unsigned char* ws, LAS float* scr, int r, int lane) {
    const float* const* tab = (const float* const*)(ws + WS_PTAB);
    if (r < 2 * I_OUT) { transpose_half_item<false>(tab[0], DM, DM, (bf16_t*)(ws + WS_WOUT), nullptr, scr, r, lane); return; } r -= 2 * I_OUT;
    if (r < 2 * I_UP) { transpose_half_item<true>(tab[1], DM, NUP, (bf16_t*)(ws + WS_WUP), tab[2], scr, r, lane); return; } r -= 2 * I_UP;
    if (r < 2 * I_DOWN) { transpose_half_item<false>(tab[3], DFF, DM, (bf16_t*)(ws + WS_WDOWN), nullptr, scr, r, lane); return; } r -= 2 * I_DOWN;
    if (r < 2 * I_PROJ) { transpose_half_item<false>(tab[4], PLE, DM, (bf16_t*)(ws + WS_WPROJ), nullptr, scr, r, lane); return; } r -= 2 * I_PROJ;
    transpose_half_item<false>(tab[5], DM, DM, (bf16_t*)(ws + WS_WGATE), tab[6], scr, r, lane);
}
__device__ __forceinline__ void phase0(const Args& A, LAS unsigned char* lds, int tid, int lane, int wave) {
    unsigned char* ws = A.ws;
    LAS float* scr = (LAS float*)(lds + wave * 16384);
    const int gw = blockIdx.x * 8 + wave, NGW = gridDim.x * 8;
    for (int it = gw; it < N_EARLY; it += NGW) {
        int r = it;
        if (r < I_IN) { p0_transpose_item<false>(A.in[3], DM, NZ, (bf16_t*)(ws + WS_WIN), A.in[2], scr, r, lane); continue; } r -= I_IN;
        bf16_t* WLp = (bf16_t*)(ws + WS_WLORA);
        if (r < I_LW) { p0_transpose_item<false>(A.in[7], 64, 512, WLp, nullptr, scr, r, lane, KLORA); continue; } r -= I_LW;
        if (r < I_LA) { p0_transpose_item<false>(A.in[9], 64, 512, WLp + (size_t)512 * KLORA + 64, nullptr, scr, r, lane, KLORA); continue; } r -= I_LA;
        p0_transpose_item<false>(A.in[10], 128, 512, WLp + (size_t)1024 * KLORA + 128, nullptr, scr, r, lane, KLORA);
    }
    {
        bf16_t* WL = (bf16_t*)(ws + WS_WLORA);
        const int gt = blockIdx.x * 512 + tid, NT = gridDim.x * 512;
        for (int ci = gt; ci < NLORA * (KLORA / 8); ci += NT) {
            const int n = ci / (KLORA / 8), k = (ci % (KLORA / 8)) * 8;
            const bool diag = n < 512 ? (k < 64) : (n < 1024 ? (k >= 64 && k < 128) : (k >= 128));
            if (!diag) *(uint4*)(WL + (size_t)n * KLORA + k) = make_uint4(0, 0, 0, 0);
        }
        float* ss = (float*)(ws + WS_SS);
        for (int i = gt; i < 4 * MTOK; i += NT) ss[MTOK + i] = 0.f;
    }
    if (blockIdx.x == 0) { unsigned* bw = (unsigned*)(ws + WS_BAR); for (int i = tid; i < 4096; i += 512) bw[i] = 0u; }
    if (blockIdx.x == 0 && tid == 0) { const float** tab = (const float**)(ws + WS_PTAB); tab[0] = A.in[16]; tab[1] = A.in[18]; tab[2] = A.in[17]; tab[3] = A.in[21]; tab[4] = A.in[22]; tab[5] = A.in[25]; tab[6] = A.in[24]; tab[7] = A.in[4]; tab[8] = A.in[1]; }
    {
        const float* x = A.in[0]; bf16_t* xb = (bf16_t*)(ws + WS_XB); float* ss1 = (float*)(ws + WS_SS);
        for (int m0 = gw; m0 < MTOK; m0 += 4 * NGW) {
            f32x4 v[4][4];
#pragma unroll
            for (int r = 0; r < 4; ++r) {
                const int m = (m0 + r * NGW < MTOK) ? m0 + r * NGW : m0;
                const f32x4* xr = (const f32x4*)(x + (size_t)m * DM) + lane;
#pragma unroll
                for (int j = 0; j < 4; ++j) v[r][j] = xr[64 * j];
            }
#pragma unroll
            for (int r = 0; r < 4; ++r) {
                const int m = m0 + r * NGW;
                float s_ = 0.f;
#pragma unroll
                for (int j = 0; j < 4; ++j) s_ += (v[r][j].x * v[r][j].x + v[r][j].y * v[r][j].y) + (v[r][j].z * v[r][j].z + v[r][j].w * v[r][j].w);
                s_ = wave_sum(s_);
                if (m < MTOK) {
                    if (lane == 0) ss1[m] = s_;
                    uint2* o8 = (uint2*)(xb + (size_t)m * DM) + lane;
#pragma unroll
                    for (int j = 0; j < 4; ++j) { uint2 o; o.x = cvt_pk_bf16(v[r][j].x, v[r][j].y); o.y = cvt_pk_bf16(v[r][j].z, v[r][j].w); o8[64 * j] = o; }
                }
            }
        }
    }
}

__device__ __forceinline__ void phase2(const Args& A, int lane, int wave) {
    unsigned char* ws = A.ws;
    const bf16_t* z = (const bf16_t*)(ws + WS_Z); bf16_t* L = (bf16_t*)(ws + WS_L);
    const float* mu = A.in[5];
    const int gw = blockIdx.x * 8 + wave, NGW = gridDim.x * 8;
    const int hl = lane >> 5, l32 = lane & 31, c = 8 * l32;
    float mu8[8];
#pragma unroll
    for (int i = 0; i < 8; ++i) mu8[i] = mu[1536 + c + i];
    for (int strip = gw; strip < MTOK / 16; strip += NGW) {
        const int row0 = strip * 16;
#pragma unroll
        for (int i4 = 0; i4 < 16; i4 += 8) {
            uint4 zc[4], zp[4];
#pragma unroll
            for (int r = 0; r < 4; ++r) {
                const int row = row0 + i4 + 2 * r + hl;
                zc[r] = *(const uint4*)(z + (size_t)row * NZ + ZC_L + c);
                zp[r] = ((row & (SEQ - 1)) != 0) ? *(const uint4*)(z + (size_t)(row - 1) * NZ + ZC_L + c) : make_uint4(0, 0, 0, 0);
            }
#pragma unroll
            for (int r = 0; r < 4; ++r) {
                const size_t row = (size_t)(row0 + i4 + 2 * r + hl);
                float a[8], p[8], o[8]; unpack8(zc[r], a); unpack8(zp[r], p);
#pragma unroll
                for (int j = 0; j < 8; ++j) { const float v = a[j] + (p[j] - a[j]) * mu8[j]; o[j] = (l32 < 8) ? tanhf(v) : ((l32 < 16) ? v : sigmoidf_(v)); }
                *(uint4*)(L + row * KLORA + c) = pack8(o);
            }
        }
    }
}

constexpr int TC = 32;
constexpr int SC_VEC = TC * 64;
constexpr int SC_BUF = 5 * SC_VEC + TC * 32;
struct ScanRegs { uint2 rc, rp, kc, kp, ac, dec; unsigned vc, vp; };
__device__ __forceinline__ void scan_load(ScanRegs& R, const bf16_t* z, const bf16_t* abuf, const bf16_t* dec, int b, int h, int half, int chunk, int tl, int kq) {
    const int t = chunk * TC + tl; const size_t row = (size_t)b * SEQ + t;
    const bf16_t* zr = z + row * NZ;
    R.rc = *(const uint2*)(zr + ZC_R + h * 64 + 4 * kq); R.kc = *(const uint2*)(zr + ZC_K + h * 64 + 4 * kq);
    R.vc = *(const unsigned*)(zr + ZC_V + h * 64 + 32 * half + 2 * kq);
    if (t > 0) { R.rp = *(const uint2*)(zr - NZ + ZC_R + h * 64 + 4 * kq); R.kp = *(const uint2*)(zr - NZ + ZC_K + h * 64 + 4 * kq); R.vp = *(const unsigned*)(zr - NZ + ZC_V + h * 64 + 32 * half + 2 * kq); }
    else { R.rp = make_uint2(0, 0); R.kp = make_uint2(0, 0); R.vp = 0u; }
    R.ac = *(const uint2*)(abuf + row * 512 + h * 64 + 4 * kq);
    R.dec = *(const uint2*)(dec + row * 512 + h * 64 + 4 * kq);
}
__device__ __forceinline__ void scan_store(const ScanRegs& R, LAS float* buf, const float* mu, const float* k_k, const float* k_a, const float* r_k, const float* w0, const float* a0, float* cbrow, int h, int half, int tl, int kq) {
    float rc[4], rp[4], kc[4], kp[4], a[4];
    unpack4(R.rc, rc); unpack4(R.rp, rp); unpack4(R.kc, kc); unpack4(R.kp, kp); unpack4(R.ac, a);
    const int ch = h * 64 + 4 * kq;
    const f32x4 mur = *(const f32x4*)(mu + ch), muk = *(const f32x4*)(mu + 512 + ch), kk4 = *(const f32x4*)(k_k + ch), ka4 = *(const f32x4*)(k_a + ch);
    {
        const f32x4 a04 = *(const f32x4*)(a0 + ch);
#pragma unroll
        for (int i = 0; i < 4; ++i) a[i] = sigmoidf_(a[i] + a04[i]);
    }
    float r[4], k[4], kk[4]; float ss = 0.f;
#pragma unroll
    for (int i = 0; i < 4; ++i) { r[i] = rc[i] + (rp[i] - rc[i]) * mur[i]; k[i] = kc[i] + (kp[i] - kc[i]) * muk[i]; kk[i] = k[i] * kk4[i]; ss += kk[i] * kk[i]; }
    ss = reduce16(ss);
    const float rn = rsqrtf(fmaxf(ss, 1e-24f));
    f32x4 nkk, kka, kpr, rr;
#pragma unroll
    for (int i = 0; i < 4; ++i) { const float kn = kk[i] * rn; nkk[i] = -kn; kka[i] = kn * a[i]; kpr[i] = k[i] * (1.0f + (a[i] - 1.0f) * ka4[i]); rr[i] = r[i]; }
    {
        const f32x4 rk4 = *(const f32x4*)(r_k + ch);
        float cbp = (r[0] * kpr[0] * rk4[0] + r[1] * kpr[1] * rk4[1]) + (r[2] * kpr[2] * rk4[2] + r[3] * kpr[3] * rk4[3]);
        cbp = reduce16(cbp);
        if (half == 0 && kq == 0) cbrow[(size_t)tl * 8] = cbp;
    }
    const int o = tl * 64 + 4 * kq;
    {
        float e4[4]; unpack4(R.dec, e4); const f32x4 w04 = *(const f32x4*)(w0 + ch);
        f32x4 wv;
#pragma unroll
        for (int i = 0; i < 4; ++i) wv[i] = __expf(-0.60653065971f * sigmoidf_(e4[i] + w04[i]));
        *(LAS f32x4*)(buf + o) = wv;
    }
    *(LAS f32x4*)(buf + SC_VEC + o) = nkk; *(LAS f32x4*)(buf + 2 * SC_VEC + o) = kka; *(LAS f32x4*)(buf + 3 * SC_VEC + o) = kpr; *(LAS f32x4*)(buf + 4 * SC_VEC + o) = rr;
    const int vch = h * 64 + 32 * half + 2 * kq;
    const float v0c = __uint_as_float(R.vc << 16), v1c = __uint_as_float(R.vc & 0xffff0000u), v0p = __uint_as_float(R.vp << 16), v1p = __uint_as_float(R.vp & 0xffff0000u);
    const float m0 = mu[1024 + vch], m1 = mu[1024 + vch + 1];
    buf[5 * SC_VEC + tl * 32 + 2 * kq] = v0c + (v0p - v0c) * m0; buf[5 * SC_VEC + tl * 32 + 2 * kq + 1] = v1c + (v1p - v1c) * m1;
}
struct StepVec { f32x4 w0, w1, a0, a1, k0, k1, r0, r1; float vv; };
struct StepN { f32x4 n0, n1; };
__device__ __forceinline__ void sv_load(StepVec& V, const LAS float* pk, const LAS float* pv, int t) {
    const LAS float* p = pk + t * 64;
    V.a0 = *(const LAS f32x4*)(p + 2 * SC_VEC); V.a1 = *(const LAS f32x4*)(p + 2 * SC_VEC + 4);
    V.k0 = *(const LAS f32x4*)(p + 3 * SC_VEC); V.k1 = *(const LAS f32x4*)(p + 3 * SC_VEC + 4);
    V.vv = pv[t * 32];
    V.w0 = *(const LAS f32x4*)(p); V.w1 = *(const LAS f32x4*)(p + 4);
    V.r0 = *(const LAS f32x4*)(p + 4 * SC_VEC); V.r1 = *(const LAS f32x4*)(p + 4 * SC_VEC + 4);
}
__device__ __forceinline__ void sn_load(StepN& N, const LAS float* pk, int t) {
    const LAS float* p = pk + t * 64 + SC_VEC;
    N.n0 = *(const LAS f32x4*)(p); N.n1 = *(const LAS f32x4*)(p + 4);
}
__device__ __forceinline__ float dot8(const f32x4& a, const f32x4& b, const f32x4& x, const f32x4& y) {
    float r = a.x * x.x; r = __builtin_fmaf(a.y, x.y, r); r = __builtin_fmaf(a.z, x.z, r); r = __builtin_fmaf(a.w, x.w, r);
    r = __builtin_fmaf(b.x, y.x, r); r = __builtin_fmaf(b.y, y.y, r); r = __builtin_fmaf(b.z, y.z, r); r = __builtin_fmaf(b.w, y.w, r); return r; }
__device__ __forceinline__ float reduce8(float x) { x += dppf<0xB1>(x); x += dppf<0x4E>(x); x += dppf<0x141>(x); return x; }
__device__ __forceinline__ void reduce8x2(float& x, float& y) { x += dppf<0xB1>(x); y += dppf<0xB1>(y); x += dppf<0x4E>(x); y += dppf<0x4E>(y); x += dppf<0x141>(x); y += dppf<0x141>(y); }
#define SCAN_STEP(CUR, NXT, NC, NN, T) do { \
        if ((T) + 2 < TC) sn_load(NC, pk, (T) + 2); \
        if ((T) + 1 < TC) sv_load(NXT, pk, pv, (T) + 1); \
        __builtin_amdgcn_sched_barrier(0);     \
        sA = sA * CUR.w0 + (CUR.a0 * sa + CUR.k0 * CUR.vv); sB = sB * CUR.w1 + (CUR.a1 * sa + CUR.k1 * CUR.vv); \
        float op_ = dot8(sA, sB, CUR.r0, CUR.r1); \
        if ((T) + 1 < TC) { float sp_ = dot8(sA, sB, NN.n0, NN.n1); reduce8x2(op_, sp_); sa = sp_; } else { op_ = reduce8(op_); } \
        oacc = (kq == ((T) & 7)) ? op_ : oacc; \
        if (((T) & 7) == 7) ost[((T) - 7 + kq) * 33 + row] = oacc; \
    } while (0)
__device__ __forceinline__ void scan_compute_chunk(f32x4& sA, f32x4& sB, const LAS float* buf, LAS float* ost, int row, int kq) {
    const LAS float* pk = buf + 8 * kq; const LAS float* pv = buf + 5 * SC_VEC + row;
    StepVec VA, VB; StepN N0, N1;
    sn_load(N0, pk, 0); sn_load(N1, pk, 1); sv_load(VA, pk, pv, 0);
    float sa = reduce8(dot8(sA, sB, N0.n0, N0.n1));
    float oacc = 0.f;
#pragma unroll
    for (int t2 = 0; t2 < TC / 2; ++t2) { SCAN_STEP(VA, VB, N0, N1, 2 * t2); SCAN_STEP(VB, VA, N1, N0, 2 * t2 + 1); }
}
__device__ __forceinline__ void scan_drain(const LAS float* ost, bf16_t* O, int b, int h, int half, int chunk, int ptid) {
    const int t = ptid >> 3, q = ptid & 7;
    const LAS float* p = ost + t * 33 + 4 * q;
    uint2 v; v.x = cvt_pk_bf16(p[0], p[1]); v.y = cvt_pk_bf16(p[2], p[3]);
    *(uint2*)(O + ((size_t)b * SEQ + chunk * TC + t) * 512 + h * 64 + 32 * half + 4 * q) = v;
}
struct YConv { f32x4 w0a, w0b, w1a, w1b, w2a, w2b, q1a, q1b, q2a, q2b; uint4 xq, bq, cq; int strip, row, end, pend; };
__device__ __forceinline__ void yconv_begin(YConv& Y, const bf16_t* z, const float* cwp, int lane) {
    const int c = 8 * lane;
    Y.w0a = *(const f32x4*)(cwp + c); Y.w0b = *(const f32x4*)(cwp + c + 4); Y.w1a = *(const f32x4*)(cwp + 512 + c); Y.w1b = *(const f32x4*)(cwp + 512 + c + 4);
    Y.w2a = *(const f32x4*)(cwp + 1024 + c); Y.w2b = *(const f32x4*)(cwp + 1024 + c + 4);
    Y.row = Y.strip * 32; Y.end = Y.row + 32;
    Y.q1a = (f32x4){0.f, 0.f, 0.f, 0.f}; Y.q1b = Y.q1a; Y.q2a = Y.q1a; Y.q2b = Y.q1a;
    if ((Y.row & (SEQ - 1)) != 0) {
        float xa[8], ca[8];
        unpack8(*(const uint4*)(z + (size_t)(Y.row - 1) * NZ + c), xa); unpack8(*(const uint4*)(z + (size_t)(Y.row - 1) * NZ + 1024 + c), ca);
        Y.q1a = (f32x4){xa[0] * ca[0], xa[1] * ca[1], xa[2] * ca[2], xa[3] * ca[3]}; Y.q1b = (f32x4){xa[4] * ca[4], xa[5] * ca[5], xa[6] * ca[6], xa[7] * ca[7]};
        unpack8(*(const uint4*)(z + (size_t)(Y.row - 2) * NZ + c), xa); unpack8(*(const uint4*)(z + (size_t)(Y.row - 2) * NZ + 1024 + c), ca);
        Y.q2a = (f32x4){xa[0] * ca[0], xa[1] * ca[1], xa[2] * ca[2], xa[3] * ca[3]}; Y.q2b = (f32x4){xa[4] * ca[4], xa[5] * ca[5], xa[6] * ca[6], xa[7] * ca[7]};
    }
}
__device__ __forceinline__ void yconv_issue(YConv& Y, const bf16_t* z, int lane) {
    const int c = 8 * lane; const bf16_t* zr = z + (size_t)Y.row * NZ;
    Y.xq = *(const uint4*)(zr + c); Y.bq = *(const uint4*)(zr + 512 + c); Y.cq = *(const uint4*)(zr + 1024 + c); Y.pend = 1;
}
__device__ __forceinline__ void yconv_finish(YConv& Y, bf16_t* ycat, int lane) {
    const int c = 8 * lane;
    float xa[8], ba[8], ca[8];
    unpack8(Y.xq, xa); unpack8(Y.bq, ba); unpack8(Y.cq, ca);
    const f32x4 qa = (f32x4){xa[0] * ca[0], xa[1] * ca[1], xa[2] * ca[2], xa[3] * ca[3]}, qb = (f32x4){xa[4] * ca[4], xa[5] * ca[5], xa[6] * ca[6], xa[7] * ca[7]};
    const f32x4 ya = (f32x4){ba[0], ba[1], ba[2], ba[3]} * (Y.w0a * Y.q2a + Y.w1a * Y.q1a + Y.w2a * qa), yb = (f32x4){ba[4], ba[5], ba[6], ba[7]} * (Y.w0b * Y.q2b + Y.w1b * Y.q1b + Y.w2b * qb);
    Y.q2a = Y.q1a; Y.q2b = Y.q1b; Y.q1a = qa; Y.q1b = qb;
    uint4 o; o.x = cvt_pk_bf16(ya[0], ya[1]); o.y = cvt_pk_bf16(ya[2], ya[3]); o.z = cvt_pk_bf16(yb[0], yb[1]); o.w = cvt_pk_bf16(yb[2], yb[3]);
    *(uint4*)(ycat + (size_t)Y.row * DM + c) = o;
    ++Y.row; Y.pend = 0;
}
#define SCAN_BAR() do { asm volatile("s_waitcnt lgkmcnt(0)" ::: "memory"); __builtin_amdgcn_s_barrier(); asm volatile("" ::: "memory"); } while (0)
__device__ __forceinline__ void phase3(const Args& A, LAS unsigned char* lds, int tid, int lane, int wave) {
    unsigned char* ws = A.ws;
    const bf16_t* z = (const bf16_t*)(ws + WS_Z); const bf16_t* abuf = (const bf16_t*)(ws + WS_A); const bf16_t* dec = (const bf16_t*)(ws + WS_DEC); bf16_t* O = (bf16_t*)(ws + WS_O);
    const float* mu = A.in[5]; const float* k_k = A.in[11]; const float* k_a = A.in[12]; const float* r_k = A.in[13]; float* CB = (float*)(ws + WS_CB); const float* w0p = A.in[6]; const float* a0p = A.in[8];
    LAS float* lbuf = (LAS float*)lds;
    LAS float* ostage = lbuf + 2 * SC_BUF;
    constexpr int NCH = SEQ / TC;
    int late_it = (wave >= 4) ? (int)blockIdx.x * 4 + (wave - 4) : N_LATE; const int late_stride = (int)gridDim.x * 4;
    for (int unit = blockIdx.x; unit < NB * NHEAD * 2; unit += gridDim.x) {
        const int bh = unit >> 1, half = unit & 1, b = bh >> 3, h = bh & 7;
        {
            ScanRegs R; scan_load(R, z, abuf, dec, b, h, half, 0, tid >> 4, tid & 15);
            scan_store(R, lbuf, mu, k_k, k_a, r_k, w0p, a0p, CB + ((size_t)b * SEQ) * 8 + h, h, half, tid >> 4, tid & 15);
        }
        if (wave < 4) {
            f32x4 sA = (f32x4){0.f, 0.f, 0.f, 0.f}, sB = sA;
            const int row = 8 * wave + (lane >> 3), kq = lane & 7;
            SCAN_BAR();
            for (int c = 0; c < NCH; ++c) {
                scan_compute_chunk(sA, sB, lbuf + (c & 1) * SC_BUF, ostage + (c & 1) * (32 * 33), row, kq);
                SCAN_BAR();
            }
        } else {
            const int ptid = tid - 256, tl = ptid >> 4, kq = ptid & 15;
            LAS float* wscr = lbuf + (2 * SC_BUF + 2 * 32 * 33) + (wave - 4) * (64 * 33);
            const float* cwp = ((const float* const*)(ws + WS_PTAB))[7]; bf16_t* ycat = (bf16_t*)(ws + WS_YCAT);
            YConv Y; Y.strip = unit * 4 + (wave - 4); Y.pend = 0; Y.xq = make_uint4(0, 0, 0, 0); Y.bq = Y.xq; Y.cq = Y.xq;
            yconv_begin(Y, z, cwp, lane);
            const float* pin = ((const float* const*)(ws + WS_PTAB))[8]; bf16_t* pbo = (bf16_t*)(ws + WS_PB);
            int prow = Y.strip * 32; const int prow_end = prow + 32;
            ScanRegs R0, R1;
            scan_load(R0, z, abuf, dec, b, h, half, 1, tl, kq); scan_load(R1, z, abuf, dec, b, h, half, 1, tl + 16, kq);
            SCAN_BAR();
            for (int c = 0; c < NCH; ++c) {
                if (c >= 33 && (c & 1) && late_it < N_LATE) { late_weight_item(ws, wscr, late_it, lane); late_it += late_stride; }
                if (c >= 34 && !(c & 1) && prow < prow_end) {
                    f32x4 pq[4];
#pragma unroll
                    for (int r = 0; r < 4; ++r) pq[r] = *(const f32x4*)(pin + (size_t)(prow + r) * PLE + 4 * lane);
#pragma unroll
                    for (int r = 0; r < 4; ++r) { uint2 po; po.x = cvt_pk_bf16(pq[r].x, pq[r].y); po.y = cvt_pk_bf16(pq[r].z, pq[r].w); *(uint2*)(pbo + (size_t)(prow + r) * PLE + 4 * lane) = po; }
                    prow += 4;
                }
                if (Y.pend) yconv_finish(Y, ycat, lane);
                if (c >= 1) scan_drain(ostage + ((c - 1) & 1) * (32 * 33), O, b, h, half, c - 1, ptid);
                if (c + 1 < NCH) {
                    LAS float* nb = lbuf + ((c + 1) & 1) * SC_BUF;
                    float* cbr = CB + ((size_t)b * SEQ + (size_t)(c + 1) * TC) * 8 + h;
                    scan_store(R0, nb, mu, k_k, k_a, r_k, w0p, a0p, cbr, h, half, tl, kq); scan_store(R1, nb, mu, k_k, k_a, r_k, w0p, a0p, cbr, h, half, tl + 16, kq);
                    if (c + 2 < NCH) { scan_load(R0, z, abuf, dec, b, h, half, c + 2, tl, kq); scan_load(R1, z, abuf, dec, b, h, half, c + 2, tl + 16, kq); }
                }
                if (Y.row < Y.end) yconv_issue(Y, z, lane);
                SCAN_BAR();
            }
            scan_drain(ostage + ((NCH - 1) & 1) * (32 * 33), O, b, h, half, NCH - 1, ptid);
            while (Y.row < Y.end) { if (!Y.pend) yconv_issue(Y, z, lane); yconv_finish(Y, ycat, lane); }
            for (; prow < prow_end; ++prow) { const f32x4 pv = *(const f32x4*)(pin + (size_t)prow * PLE + 4 * lane); uint2 po; po.x = cvt_pk_bf16(pv.x, pv.y); po.y = cvt_pk_bf16(pv.z, pv.w); *(uint2*)(pbo + (size_t)prow * PLE + 4 * lane) = po; }
        }
        __syncthreads();
    }
    if (wave >= 4) {
        LAS float* wscr = lbuf + (2 * SC_BUF + 2 * 32 * 33) + (wave - 4) * (64 * 33);
        for (; late_it < N_LATE; late_it += late_stride) late_weight_item(ws, wscr, late_it, lane);
    }
}

__device__ __forceinline__ void phase4(const Args& A, int lane, int wave) {
    unsigned char* ws = A.ws;
    const bf16_t* z = (const bf16_t*)(ws + WS_Z); const bf16_t* gbuf = (const bf16_t*)(ws + WS_G); const bf16_t* O = (const bf16_t*)(ws + WS_O); const float* CB = (const float*)(ws + WS_CB);
    bf16_t* ycat = (bf16_t*)(ws + WS_YCAT); bf16_t* pb = (bf16_t*)(ws + WS_PB);
    const float* mu = A.in[5]; const float* gn_w = A.in[14]; const float* gn_b = A.in[15]; const float* p = A.in[1];
    const int gw = blockIdx.x * 8 + wave, NGW = gridDim.x * 8;
    const int c = 8 * lane;
    for (int strip = gw; strip < MTOK / 16; strip += NGW) {
        const int row0 = strip * 16, t0 = row0 & (SEQ - 1);
        float muv[8], gw8[8], gb8[8];
#pragma unroll
        for (int i = 0; i < 8; ++i) { muv[i] = mu[1024 + c + i]; gw8[i] = gn_w[c + i]; gb8[i] = gn_b[c + i]; }
        uint4 vp = make_uint4(0, 0, 0, 0);
        if (t0 != 0) vp = *(const uint4*)(z + (size_t)(row0 - 1) * NZ + ZC_V + c);
        for (int i4 = 0; i4 < 16; i4 += 4) {
            uint4 vq[4], gq[4], oq[4]; float cbq[4];
#pragma unroll
            for (int r = 0; r < 4; ++r) {
                const size_t row = (size_t)(row0 + i4 + r);
                vq[r] = *(const uint4*)(z + row * NZ + ZC_V + c); gq[r] = *(const uint4*)(gbuf + row * 512 + c); oq[r] = *(const uint4*)(O + row * 512 + c);
                cbq[r] = CB[row * 8 + (lane >> 3)];
            }
#pragma unroll
            for (int r = 0; r < 4; ++r) {
                const size_t row = (size_t)(row0 + i4 + r);
                const float cb = cbq[r];
                float v[8], t8[8], g[8], o[8], y[8];
                unpack8(vq[r], v); unpack8(vp, t8);
#pragma unroll
                for (int j = 0; j < 8; ++j) v[j] += (t8[j] - v[j]) * muv[j];
                vp = vq[r];
                unpack8(gq[r], g); unpack8(oq[r], o);
                float sm = 0.f;
#pragma unroll
                for (int j = 0; j < 8; ++j) sm += o[j];
                sm += __shfl_xor(sm, 1); sm += __shfl_xor(sm, 2); sm += __shfl_xor(sm, 4);
                const float mean = sm * (1.0f / 64.0f); float vs = 0.f;
#pragma unroll
                for (int j = 0; j < 8; ++j) { o[j] -= mean; vs += o[j] * o[j]; }
                vs += __shfl_xor(vs, 1); vs += __shfl_xor(vs, 2); vs += __shfl_xor(vs, 4);
                const float rstd = rsqrtf(vs * (1.0f / 64.0f) + GN_EPS);
#pragma unroll
                for (int j = 0; j < 8; ++j) y[j] = (o[j] * rstd * gw8[j] + gb8[j] + cb * v[j]) * g[j];
                *(uint4*)(ycat + row * DM + 512 + c) = pack8(y);
            }
        }
    }
}

__device__ __forceinline__ void phase7(const Args& A, int tid) {
    unsigned char* ws = A.ws;
    const bf16_t* SB = (const bf16_t*)(ws + WS_SB); bf16_t* ACT = (bf16_t*)(ws + WS_ACT);
    const float* cw = A.in[19]; const float* cb = A.in[20];
    const int gt = blockIdx.x * 512 + tid, NT = gridDim.x * 512;
    constexpr int CPR = DFF / 4;
    for (int it = gt; it < (MTOK / 64) * CPR; it += NT) {
        const int g = it / CPR, j = (it % CPR) * 4;
        const bool first = (g & 31) == 0;
        f32x4 act[2];
        f32x4 cvv[2][2];
#pragma unroll
        for (int ty = 0; ty < 2; ++ty) {
            const int cc = ty * DFF + j;
            const f32x4 w0 = *(const f32x4*)(cw + cc), w1 = *(const f32x4*)(cw + NUP + cc), w2 = *(const f32x4*)(cw + 2 * NUP + cc), bb = *(const f32x4*)(cb + cc);
            float t4[4];
            unpack4(*(const uint2*)(SB + ((size_t)g * 4 + 0) * NUP + cc), t4); const f32x4 u0 = (f32x4){t4[0], t4[1], t4[2], t4[3]};
            unpack4(*(const uint2*)(SB + ((size_t)g * 4 + 1) * NUP + cc), t4); const f32x4 u1 = (f32x4){t4[0], t4[1], t4[2], t4[3]};
            f32x4 p62 = (f32x4){0.f, 0.f, 0.f, 0.f}, p63 = p62;
            if (!first) { unpack4(*(const uint2*)(SB + ((size_t)(g - 1) * 4 + 2) * NUP + cc), t4); p62 = (f32x4){t4[0], t4[1], t4[2], t4[3]};
                          unpack4(*(const uint2*)(SB + ((size_t)(g - 1) * 4 + 3) * NUP + cc), t4); p63 = (f32x4){t4[0], t4[1], t4[2], t4[3]}; }
            cvv[ty][0] = w2 * u0 + w1 * p63 + w0 * p62 + bb;
            cvv[ty][1] = w2 * u1 + w1 * u0 + w0 * p63 + bb;
        }
#pragma unroll
        for (int r = 0; r < 2; ++r) {
#pragma unroll
            for (int e = 0; e < 4; ++e) { const float gc = cvv[0][r][e]; act[r][e] = gc * __builtin_amdgcn_rcpf(1.0f + __expf(-gc)) * cvv[1][r][e]; }
            uint2 o; o.x = cvt_pk_bf16(act[r][0], act[r][1]); o.y = cvt_pk_bf16(act[r][2], act[r][3]);
            *(uint2*)(ACT + ((size_t)g * 64 + r) * DFF + j) = o;
        }
    }
}

__device__ __forceinline__ void phase11(const Args& A, int lane, int wave) {
    float* out = A.out; const float* ss4 = (const float*)(A.ws + WS_SS) + 4 * MTOK; const float* fg = A.in[26];
    const bf16_t* x3 = (const bf16_t*)(A.ws + WS_E);
    const int gw = blockIdx.x * 8 + wave, NGW = gridDim.x * 8;
    f32x4 g4[4];
#pragma unroll
    for (int j = 0; j < 4; ++j) g4[j] = *((const f32x4*)fg + 4 * lane + j);
    for (int m = gw; m < MTOK; m += 2 * NGW) {
        const int m2 = m + NGW; const bool has2 = m2 < MTOK; const int mb = has2 ? m2 : m;
        const float rsa = rsqrtf(ss4[m] * (1.0f / DM) + NORM_EPS), rsb = rsqrtf(ss4[mb] * (1.0f / DM) + NORM_EPS);
        const uint4 a0 = *((const uint4*)(x3 + (size_t)m * DM) + 2 * lane), a1 = *((const uint4*)(x3 + (size_t)m * DM) + 2 * lane + 1);
        const uint4 b0_ = *((const uint4*)(x3 + (size_t)mb * DM) + 2 * lane), b1_ = *((const uint4*)(x3 + (size_t)mb * DM) + 2 * lane + 1);
        float va[16], vb[16];
        unpack8(a0, va); unpack8(a1, va + 8); unpack8(b0_, vb); unpack8(b1_, vb + 8);
        f32x4* oa = (f32x4*)(out + (size_t)m * DM) + 4 * lane; f32x4* ob = (f32x4*)(out + (size_t)mb * DM) + 4 * lane;
#pragma unroll
        for (int j = 0; j < 4; ++j) {
            oa[j] = (f32x4){va[4 * j], va[4 * j + 1], va[4 * j + 2], va[4 * j + 3]} * rsa * g4[j];
            if (has2) ob[j] = (f32x4){vb[4 * j], vb[4 * j + 1], vb[4 * j + 2], vb[4 * j + 3]} * rsb * g4[j];
        }
    }
}

#define XB_TMO      128
#define XB_XCNT(j)  (256  + 64 * (j))
#define XB_XSUB(j)  (1280 + 64 * (j))
#define XB_XGEN(j)  (2304 + 64 * (j))
#define XB_TOP      3328
#define XB_TOPGEN   3392
#define XCD_BAR_WORDS 3456
#define XB_SPIN_CAP (1u << 18)

__device__ __forceinline__ unsigned xb_ld(unsigned* p)              { return __hip_atomic_load(p, __ATOMIC_RELAXED, __HIP_MEMORY_SCOPE_AGENT); }
__device__ __forceinline__ unsigned xb_add(unsigned* p, unsigned v) { return __hip_atomic_fetch_add(p, v, __ATOMIC_RELAXED, __HIP_MEMORY_SCOPE_AGENT); }
__device__ __forceinline__ unsigned xb_xcc_id() { return (unsigned)__builtin_amdgcn_s_getreg((3 << 11) | 20) & 0xFu; }
#define XB_SPIN(cond, bar) do { unsigned _sp = 0; while (cond) { __builtin_amdgcn_s_sleep(1); \
    if ((++_sp & 255u) == 0u) { if (xb_ld(&(bar)[XB_TMO])) break; if (_sp > XB_SPIN_CAP) { atomicAdd(&(bar)[XB_TMO], 1u); break; } } } } while (0)

struct XcdBarrier {
    unsigned* bar; unsigned x;
    volatile LAS unsigned* st;
};

__device__ __forceinline__ XcdBarrier xcd_barrier_post(unsigned* bar, volatile LAS unsigned* st) {
    XcdBarrier b; b.bar = bar; b.x = xb_xcc_id(); b.st = st;
    if (threadIdx.x == 0) (void)xb_add(&bar[XB_XCNT(b.x)], 1u);
    return b;
}
__device__ __forceinline__ void xcd_barrier_complete(unsigned* bar, unsigned x, unsigned& nloc, unsigned& nx) {
    const unsigned G = gridDim.x * gridDim.y * gridDim.z;
    unsigned sum, cnt, mine, sp = 0u;
    for (;;) {
        sum = 0u; cnt = 0u; mine = 0u;
#pragma unroll
        for (unsigned j = 0; j < 16; ++j) { const unsigned c = xb_ld(&bar[XB_XCNT(j)]); sum += c; cnt += (c > 0u) ? 1u : 0u; mine = (j == x) ? c : mine; }
        if (sum == G) break;
        __builtin_amdgcn_s_sleep(1);
        if ((++sp & 255u) == 0u) { if (xb_ld(&bar[XB_TMO])) break; if (sp > XB_SPIN_CAP) { atomicAdd(&bar[XB_TMO], 1u); break; } }
    }
    nloc = mine > 0u ? mine : 1u; nx = cnt > 0u ? cnt : 1u;
}

__device__ __forceinline__ void xcd_barrier(const XcdBarrier& b) {
    asm volatile("s_waitcnt vmcnt(0)" ::: "memory");
    __syncthreads();
    if (threadIdx.x == 0) {
        unsigned* bar = b.bar;
        __builtin_amdgcn_s_waitcnt(0);
        unsigned nloc = b.st[0], nx = b.st[1];
        if (nloc == 0u) { xcd_barrier_complete(bar, b.x, nloc, nx); b.st[0] = nloc; b.st[1] = nx; }
        const unsigned old = xb_add(&bar[XB_XSUB(b.x)], 1u);
        const unsigned gen = old / nloc;
        if (old + 1u == (gen + 1u) * nloc) {
            __builtin_amdgcn_fence(__ATOMIC_RELEASE, "agent");
            asm volatile("s_waitcnt vmcnt(0)" ::: "memory");
            const unsigned og = xb_add(&bar[XB_TOP], 1u);
            const unsigned tg = og / nx;
            if (og + 1u == (tg + 1u) * nx) xb_add(&bar[XB_TOPGEN], 1u);
            else XB_SPIN(xb_ld(&bar[XB_TOPGEN]) == tg, bar);
            __builtin_amdgcn_fence(__ATOMIC_ACQUIRE, "agent");
            xb_add(&bar[XB_XGEN(b.x)], 1u);
            asm volatile("s_waitcnt vmcnt(0)" ::: "memory");
        } else {
            XB_SPIN(xb_ld(&bar[XB_XGEN(b.x)]) == gen, bar);
            __builtin_amdgcn_fence(__ATOMIC_ACQUIRE, "agent");
            asm volatile("s_waitcnt vmcnt(0)" ::: "memory");
        }
    }
    __syncthreads();
}

template <int MODE> __device__ __forceinline__ void run_gemm(LAS unsigned char* lds, const bf16_t* Aop, const bf16_t* Bt, int M, int N, int K, const Epi<MODE>& E) {
    pg8::Gemm g{Aop, Bt, M, N, K}; pg8::StaticOrder S; S.init(M, N, (int)gridDim.x, (int)blockIdx.x);
    pg8::gemm_phase<Epi<MODE>, pg8::StaticOrder, true, true>(lds, g, S, E);
}

__global__ void __launch_bounds__(512, 2) hymba_fwd(Args A) {
    extern __shared__ __attribute__((aligned(16))) unsigned char lds_raw[];
    cg::grid_group grid = cg::this_grid();
    LAS unsigned char* lds = (LAS unsigned char*)lds_raw;
    int tid, lane, wave;
#define PHASE_IDS() do { tid = threadIdx.x; asm volatile("" : "+v"(tid)); lane = tid & 63; wave = __builtin_amdgcn_readfirstlane(tid >> 6); } while (0)
    PHASE_IDS();
    unsigned char* ws = A.ws;
    float* ss = (float*)(ws + WS_SS);
    bf16_t* XB = (bf16_t*)(ws + WS_XB);

#ifndef PMASK
#define PMASK 0xFFFF
#endif
    if (PMASK & 1) phase0(A, lds, tid, lane, wave);
    grid.sync();
    ((volatile LAS unsigned*)(lds + 143360))[tid & 1] = 0u; __syncthreads();
    const XcdBarrier xbar = xcd_barrier_post((unsigned*)(ws + WS_BAR), (volatile LAS unsigned*)(lds + 143360));
#define GSYNC() xcd_barrier(xbar)

    if (PMASK & 2) {
        Epi<MODE_Z> E{}; E.row_off = 0; E.b0 = (bf16_t*)(ws + WS_Z); E.ldb = NZ; E.ssin = ss;
        run_gemm<MODE_Z>(lds, XB, (const bf16_t*)(ws + WS_WIN), MTOK, NZ, DM, E);
    }
    GSYNC();
    PHASE_IDS();
    if (PMASK & 4) phase2(A, lane, wave);
    GSYNC();
    if (PMASK & 8) {
        Epi<MODE_LORA> E{}; E.row_off = 0; E.c0 = A.in[6]; E.c1 = A.in[8]; E.f1 = (float*)(ws + WS_DEC); E.b1 = (bf16_t*)(ws + WS_A); E.b2 = (bf16_t*)(ws + WS_G);
        run_gemm<MODE_LORA>(lds, (const bf16_t*)(ws + WS_L), (const bf16_t*)(ws + WS_WLORA), MTOK, NLORA, KLORA, E);
    }
    GSYNC();
    PHASE_IDS();
    if (PMASK & 16) phase3(A, lds, tid, lane, wave);
#ifdef REP_SCAN
    GSYNC(); phase3(A, lds, tid, lane, wave);
#endif
    GSYNC();
    PHASE_IDS();
    if (PMASK & 32) phase4(A, lane, wave);
    GSYNC();
    if (PMASK & 64) {
        Epi<MODE_WOUT> E{}; E.row_off = 0; E.f0 = A.out; E.xin = A.in[0]; E.b0 = XB; E.ldb = DM; E.ssout = ss + MTOK;
        run_gemm<MODE_WOUT>(lds, (const bf16_t*)(ws + WS_YCAT), (const bf16_t*)(ws + WS_WOUT), MTOK, DM, DM, E);
    }
    if (PMASK & 1024) {
        Epi<MODE_PLE> E{}; E.row_off = 0; E.b0 = (bf16_t*)(ws + WS_E); E.ldb = DM; E.ssout = ss + 3 * MTOK;
        run_gemm<MODE_PLE>(lds, (const bf16_t*)(ws + WS_PB), (const bf16_t*)(ws + WS_WPROJ), MTOK, DM, PLE, E);
    }
    GSYNC();
    if (PMASK & 128) {
        Epi<MODE_UP> E{}; E.row_off = 0; E.b0 = (bf16_t*)(ws + WS_ACT); E.ldb = DFF; E.ssin = ss + MTOK; E.c0 = A.in[19]; E.c1 = A.in[20]; E.sb = (float*)(ws + WS_SB);
        run_gemm<MODE_UP>(lds, XB, (const bf16_t*)(ws + WS_WUP), MTOK, NUP, DM, E);
    }
    GSYNC();
    PHASE_IDS();
    if (PMASK & 256) phase7(A, tid);
    GSYNC();
    if (PMASK & 512) {
        Epi<MODE_DOWN> E{}; E.row_off = 0; E.f0 = A.out; E.b0 = XB; E.ldb = DM; E.ssout = ss + 2 * MTOK;
        run_gemm<MODE_DOWN>(lds, (const bf16_t*)(ws + WS_ACT), (const bf16_t*)(ws + WS_WDOWN), MTOK, DM, DFF, E);
    }
    GSYNC();
    if (PMASK & 2048) {
        Epi<MODE_GATE> E{}; E.row_off = 0; E.f0 = A.out; E.ssin = ss + 2 * MTOK; E.e0 = (const bf16_t*)(ws + WS_E); E.ssin2 = ss + 3 * MTOK; E.c0 = A.in[23]; E.ssout = ss + 4 * MTOK; E.b0 = XB; E.ldb = DM;
        run_gemm<MODE_GATE>(lds, XB, (const bf16_t*)(ws + WS_WGATE), MTOK, DM, DM, E);
    }
    GSYNC();
    PHASE_IDS();
    if (PMASK & 4096) phase11(A, lane, wave);
}

extern "C" void kernel_launch(void* const* d_in, const int* in_sizes, int n_in, void* d_out, int out_size, void* d_ws, size_t ws_size, hipStream_t stream) {
    static int grid_blocks = 0;
    if (grid_blocks == 0) {
        int dev = 0, cus = 0, per_cu = 0;
        hipGetDevice(&dev);
        hipDeviceGetAttribute(&cus, hipDeviceAttributeMultiprocessorCount, dev);
        hipFuncSetAttribute((const void*)hymba_fwd, hipFuncAttributeMaxDynamicSharedMemorySize, LDS_BYTES);
        hipOccupancyMaxActiveBlocksPerMultiprocessor(&per_cu, (const void*)hymba_fwd, 512, LDS_BYTES);
        if (per_cu < 1) { fprintf(stderr, "kernel_launch: occupancy query says %d blocks/CU\n", per_cu); per_cu = 1; }
        if (per_cu > 1) per_cu = 1;
        grid_blocks = cus * per_cu;
        if (ws_size < 512 * MiB) fprintf(stderr, "kernel_launch: ws_size %zu < 512 MiB\n", ws_size);
    }
    Args a{};
    for (int i = 0; i < 27; ++i) a.in[i] = (const float*)d_in[i];
    a.out = (float*)d_out; a.ws = (unsigned char*)d_ws;
    void* args[] = {&a};
    hipError_t e = hipLaunchCooperativeKernel((const void*)hymba_fwd, dim3(grid_blocks), dim3(512), args, LDS_BYTES, stream);
    if (e != hipSuccess) fprintf(stderr, "cooperative launch failed: %s (grid %d)\n", hipGetErrorString(e), grid_blocks);
}
```
